# Optimizing an MI355X kernel written in HIP

```python
import math
import jax
import jax.numpy as jnp
from jax import lax
import numpy as np

D_MODEL = 2048
BATCH = 8
SEQ = 4096
DEPTH = 4
DEC_BATCH = 4
DEC_SEQ = 8192
PAST_LEN = 128

HEAD_DIM = 128
MIX_WIDTH = D_MODEL
ATTN_HEADS = MIX_WIDTH // (2 * HEAD_DIM)
ATTN_WIDTH = ATTN_HEADS * HEAD_DIM
DN_HEADS = (MIX_WIDTH - ATTN_WIDTH) // HEAD_DIM
DN_WIDTH = DN_HEADS * HEAD_DIM
DILATED_BRANCHES = ((128, 1), (512, 4), (2048, 16))
ATTN_BLOCK = 64
NUM_BUCKETS = 32
BUCKET_MAX_DISTANCE = 1024
SHORT_CONV = 3
DN_CHUNK = 64
FFN_CONV = 3
D_FF = 5632
EPS = 1e-6
NEG_INF = -1e30
SPLITS = (ATTN_WIDTH, 2 * ATTN_WIDTH, 3 * ATTN_WIDTH,
          3 * ATTN_WIDTH + 3 * DN_WIDTH,
          3 * ATTN_WIDTH + 4 * DN_WIDTH,
          3 * ATTN_WIDTH + 4 * DN_WIDTH + 2 * DN_HEADS)
IN_COLS = 3 * ATTN_WIDTH + 4 * DN_WIDTH + 4 * DN_HEADS

kernel_name = 'hybrid_dilated_attn_gated_deltanet_encoder'


def rmsnorm(x, gain):
    x32 = x.astype(jnp.float32)
    y = x32 * lax.rsqrt(jnp.mean(x32 * x32, axis=-1, keepdims=True) + EPS)
    return (y * gain.astype(jnp.float32)).astype(x.dtype)


def l2norm(x):
    x32 = x.astype(jnp.float32)
    return x32 * lax.rsqrt(jnp.sum(x32 * x32, axis=-1, keepdims=True) + EPS)


def dwconv_centred(x, w, b=None):
    k = w.shape[0]
    p = k // 2
    s = x.shape[1]
    xp = jnp.pad(x, ((0, 0), (p, p), (0, 0)))
    out = xp[:, 0:s] * w[0]
    for i in range(1, k):
        out = out + xp[:, i:i + s] * w[i]
    if b is not None:
        out = out + b
    return out


def t5_bucket(rel):
    half = NUM_BUCKETS // 2
    max_exact = half // 2
    n = jnp.abs(rel)
    base = jnp.where(rel > 0, half, 0)
    nf = jnp.maximum(n, 1).astype(jnp.float32)
    large = max_exact + (jnp.log(nf / max_exact) / math.log(BUCKET_MAX_DISTANCE / max_exact)
                         * (half - max_exact)).astype(jnp.int32)
    large = jnp.minimum(large, half - 1)
    return base + jnp.where(n < max_exact, n, large)


def dilated_branch(q, k, v, window, dilation, rel_bias):
    b, s, h, dh = q.shape
    radius = window // (2 * dilation)
    blk = ATTN_BLOCK
    l = s // dilation
    nb = -(-l // blk)
    lp = nb * blk
    g = b * dilation

    def to_sub(t):
        x = t.shape[-1]
        return t.reshape(b, l, dilation, h, x).transpose(0, 2, 1, 3, 4).reshape(g, l, h, x)

    def from_sub(t):
        x = t.shape[-1]
        t = t.reshape(g, lp, h, x)[:, :l]
        return t.reshape(b, dilation, l, h, x).transpose(0, 2, 1, 3, 4).reshape(b, s, h, x)

    def key_blocks(t):
        tp = jnp.pad(to_sub(t), ((0, 0), (blk, lp - l + blk), (0, 0), (0, 0))).reshape(g, nb + 2, blk, h, dh)
        return jnp.concatenate([tp[:, :-2], tp[:, 1:-1], tp[:, 2:]], axis=2)

    qb = jnp.pad(to_sub(q), ((0, 0), (0, lp - l), (0, 0), (0, 0))).reshape(g, nb, blk, h, dh)
    kb = key_blocks(k)
    vb = key_blocks(v)
    logits = jnp.einsum('gnqhd,gnkhd->gnqhk', qb.astype(jnp.float32), kb.astype(jnp.float32))
    delta = jnp.arange(3 * blk)[None, :] - blk - jnp.arange(blk)[:, None]
    band = jnp.abs(delta) <= radius
    bias = jnp.take(rel_bias, t5_bucket(delta * dilation), axis=0).transpose(0, 2, 1)
    key_pos = jnp.arange(nb)[:, None] * blk + jnp.arange(3 * blk)[None, :] - blk
    valid = (key_pos >= 0) & (key_pos < l)
    mask = band[None, None, :, None, :] & valid[None, :, None, None, :]
    logits = jnp.where(mask, logits + bias[None, None].astype(jnp.float32), NEG_INF)
    m = jnp.max(logits, axis=-1, keepdims=True)
    p = jnp.exp(logits - m)
    den = jnp.sum(p, axis=-1, keepdims=True)
    o = jnp.einsum('gnqhk,gnkhd->gnqhd', p, vb.astype(jnp.float32))
    return from_sub(o), from_sub(m), from_sub(den)


def dilated_attention(q, k, v, rel_bias):
    outs = [dilated_branch(q, k, v, w, d, rel_bias) for (w, d) in DILATED_BRANCHES]
    m_all = jnp.max(jnp.stack([m for (_, m, _) in outs], axis=0), axis=0)
    num = jnp.zeros(q.shape, jnp.float32)
    den = jnp.zeros(q.shape[:-1] + (1,), jnp.float32)
    for (o, m, s) in outs:
        wgt = jnp.exp(m - m_all)
        num = num + wgt * o
        den = den + wgt * s
    return num / den


def gated_delta_chunked(q, k, v, g, beta):
    b, s, h, dk = q.shape
    dv = v.shape[-1]
    c = DN_CHUNK
    n = s // c

    def to_chunks(t):
        t = t.astype(jnp.float32).reshape((b, n, c) + t.shape[2:])
        return jnp.moveaxis(t, 2, 3)

    qc, kc, vc = to_chunks(q), to_chunks(k), to_chunks(v)
    gc = jnp.cumsum(to_chunks(g), axis=-1)
    bc = to_chunks(beta)
    idx = jnp.arange(c)
    incl = idx[:, None] >= idx[None, :]
    strict = idx[:, None] > idx[None, :]
    decay = jnp.exp(jnp.where(incl, gc[..., :, None] - gc[..., None, :], NEG_INF))
    kk = jnp.einsum('bnhid,bnhjd->bnhij', kc, kc)
    a_mat = jnp.where(strict, kk * decay * bc[..., :, None], 0.0) + jnp.eye(c, dtype=jnp.float32)
    u = lax.linalg.triangular_solve(a_mat, vc * bc[..., None], left_side=True, lower=True, unit_diagonal=True)
    w = lax.linalg.triangular_solve(a_mat, kc * (bc * jnp.exp(gc))[..., None], left_side=True, lower=True,
                                    unit_diagonal=True)
    qk = jnp.einsum('bnhid,bnhjd->bnhij', qc, kc) * decay
    q_dec = qc * jnp.exp(gc)[..., None]
    g_last = gc[..., -1]
    k_dec = kc * jnp.exp(g_last[..., None] - gc)[..., None]

    def step(state, xs):
        u_n, w_n, qk_n, qdec_n, kdec_n, glast_n = xs
        v_new = u_n - jnp.einsum('bhcd,bhde->bhce', w_n, state)
        o_n = jnp.einsum('bhcd,bhde->bhce', qdec_n, state) + jnp.einsum('bhij,bhje->bhie', qk_n, v_new)
        state = state * jnp.exp(glast_n)[..., None, None] + jnp.einsum('bhcd,bhce->bhde', kdec_n, v_new)
        return state, o_n

    xs = tuple(jnp.moveaxis(t, 1, 0) for t in (u, w, qk, q_dec, k_dec, g_last))
    state0 = jnp.zeros((b, h, dk, dv), jnp.float32)
    _, o = lax.scan(step, state0, xs)
    return jnp.swapaxes(jnp.moveaxis(o, 0, 1), 2, 3).reshape(b, s, h, dv)


def token_mixer(h, rel_bias, w_in, dn_conv_w, dn_a_log, dn_dt_bias, attn_out_gain, dn_out_gain, w_out):
    b, s, _ = h.shape
    proj = h @ w_in
    qa, ka, va, qkv_dn, z, beta_logit, a_logit = jnp.split(proj, SPLITS, axis=-1)
    heads = lambda t, nh: t.reshape(b, s, nh, HEAD_DIM)

    attn = dilated_attention(heads(qa, ATTN_HEADS) * (HEAD_DIM ** -0.5), heads(ka, ATTN_HEADS),
                             heads(va, ATTN_HEADS), rel_bias)
    attn = rmsnorm(attn, attn_out_gain)

    qkv_dn = jax.nn.silu(dwconv_centred(qkv_dn, dn_conv_w))
    qd, kd, vd = jnp.split(qkv_dn, 3, axis=-1)
    qd = l2norm(heads(qd, DN_HEADS)) * (HEAD_DIM ** -0.5)
    kd = l2norm(heads(kd, DN_HEADS))
    vd = heads(vd, DN_HEADS).astype(jnp.float32)
    beta = jax.nn.sigmoid(beta_logit.astype(jnp.float32)).reshape(b, s, 2, DN_HEADS)
    g = -jnp.exp(dn_a_log.astype(jnp.float32)) * jax.nn.softplus(
        a_logit.astype(jnp.float32).reshape(b, s, 2, DN_HEADS) + dn_dt_bias.astype(jnp.float32))
    flip = lambda t: jnp.flip(t, axis=1)
    o_fwd = gated_delta_chunked(qd, kd, vd, g[:, :, 0], beta[:, :, 0])
    o_bwd = flip(gated_delta_chunked(flip(qd), flip(kd), flip(vd), flip(g[:, :, 1]), flip(beta[:, :, 1])))
    dn = rmsnorm(o_fwd + o_bwd, dn_out_gain) * jax.nn.silu(heads(z, DN_HEADS).astype(jnp.float32))

    mix = jnp.concatenate([attn.reshape(b, s, ATTN_WIDTH), dn.reshape(b, s, DN_WIDTH)], axis=-1)
    return mix.astype(h.dtype) @ w_out


def conv_ffn(h, w_up, ffn_conv_w, ffn_conv_b, w_down):
    u = dwconv_centred(h @ w_up, ffn_conv_w, ffn_conv_b)
    gate, up = jnp.split(u, 2, axis=-1)
    return (jax.nn.silu(gate) * up) @ w_down


def trunk(x, rel_bias, norm_pre_mix, w_in, dn_conv_w, dn_a_log, dn_dt_bias, attn_out_gain, dn_out_gain,
          w_out, norm_post_mix, norm_pre_ffn, w_up, ffn_conv_w, ffn_conv_b, w_down, norm_post_ffn):
    for l in range(DEPTH):
        mixed = token_mixer(rmsnorm(x, norm_pre_mix[l]), rel_bias, w_in[l], dn_conv_w[l], dn_a_log[l],
                            dn_dt_bias[l], attn_out_gain[l], dn_out_gain[l], w_out[l])
        x = x + rmsnorm(mixed, norm_post_mix[l])
        f = conv_ffn(rmsnorm(x, norm_pre_ffn[l]), w_up[l], ffn_conv_w[l], ffn_conv_b[l], w_down[l])
        x = x + rmsnorm(f, norm_post_ffn[l])
    return x


def setup_inputs(seed: int = 0) -> dict:
    key = jax.random.key(seed)
    ks = jax.random.split(key, 20)
    f32 = jnp.float32
    nrm = lambda k, shape, scale: scale * jax.random.normal(k, shape, f32)
    gain = lambda k, shape: 1.0 + 0.05 * jax.random.normal(k, shape, f32)
    a_init = jax.random.uniform(ks[7], (DEPTH, 2, DN_HEADS), f32, 1.0, 16.0)
    dt = jnp.exp(jax.random.uniform(ks[8], (DEPTH, 2, DN_HEADS), f32, math.log(1e-3), math.log(1e-1)))
    return {
        'x_prompt': jax.random.normal(ks[0], (BATCH, SEQ, D_MODEL), f32),
        'x_sample': jax.random.normal(ks[1], (DEC_BATCH, DEC_SEQ, D_MODEL), f32),
        'rel_bias': nrm(ks[2], (NUM_BUCKETS, ATTN_HEADS), 0.5),
        'norm_pre_mix': gain(ks[3], (DEPTH, D_MODEL)),
        'w_in': nrm(ks[4], (DEPTH, D_MODEL, IN_COLS), D_MODEL ** -0.5),
        'dn_conv_w': nrm(ks[5], (DEPTH, SHORT_CONV, 3 * DN_WIDTH), SHORT_CONV ** -0.5),
        'dn_a_log': jnp.log(a_init),
        'dn_dt_bias': dt + jnp.log(-jnp.expm1(-dt)),
        'attn_out_gain': gain(ks[9], (DEPTH, HEAD_DIM)),
        'dn_out_gain': gain(ks[10], (DEPTH, HEAD_DIM)),
        'w_out': nrm(ks[11], (DEPTH, MIX_WIDTH, D_MODEL), MIX_WIDTH ** -0.5),
        'norm_post_mix': gain(ks[12], (DEPTH, D_MODEL)),
        'norm_pre_ffn': gain(ks[13], (DEPTH, D_MODEL)),
        'w_up': nrm(ks[14], (DEPTH, D_MODEL, 2 * D_FF), D_MODEL ** -0.5),
        'ffn_conv_w': nrm(ks[15], (DEPTH, FFN_CONV, 2 * D_FF), FFN_CONV ** -0.5),
        'ffn_conv_b': nrm(ks[16], (DEPTH, 2 * D_FF), 0.02),
        'w_down': nrm(ks[17], (DEPTH, D_FF, D_MODEL), D_FF ** -0.5),
        'norm_post_ffn': gain(ks[18], (DEPTH, D_MODEL)),
    }


def reference(x_prompt, x_sample, rel_bias, norm_pre_mix, w_in, dn_conv_w, dn_a_log, dn_dt_bias,
              attn_out_gain, dn_out_gain, w_out, norm_post_mix, norm_pre_ffn, w_up, ffn_conv_w, ffn_conv_b,
              w_down, norm_post_ffn):
    y_prompt = trunk(x_prompt, rel_bias, norm_pre_mix, w_in, dn_conv_w, dn_a_log, dn_dt_bias, attn_out_gain,
                     dn_out_gain, w_out, norm_post_mix, norm_pre_ffn, w_up, ffn_conv_w, ffn_conv_b, w_down,
                     norm_post_ffn)
    y_sample = trunk(x_sample, rel_bias, norm_pre_mix, w_in, dn_conv_w, dn_a_log, dn_dt_bias, attn_out_gain,
                     dn_out_gain, w_out, norm_post_mix, norm_pre_ffn, w_up, ffn_conv_w, ffn_conv_b, w_down,
                     norm_post_ffn)
    return (y_prompt, y_sample)
```

```cpp
#include <hip/hip_runtime.h>
#include <cstdio>
#include <cstdint>
namespace pg8 {
#define PG8_LAS __attribute__((address_space(3)))
typedef unsigned short bf16_t;
typedef short bf16x8 __attribute__((ext_vector_type(8)));
typedef float f32x4 __attribute__((ext_vector_type(4)));
typedef unsigned u32x4 __attribute__((ext_vector_type(4)));
constexpr int BM = 256, BK = 64, HALF = 128, HTB = HALF * BK * 2  , STAGE_BYTES = 8 * HTB, NXCD = 8, WGM = 4;

__host__ __device__ __forceinline__ int lds_byte(int r, int c) { const int st = (r >> 4) * 2 + (c >> 5), rr = r & 15, cc = c & 31, ob = rr * 64 + cc * 2; return st * 1024 + (ob ^ (((ob >> 9) & 1) << 5)); }
__host__ __device__ __forceinline__ void stage_rc(int b, int& R, int& C) { const int st = b / 1024, sb = b % 1024, swz = sb ^ (((sb >> 9) & 1) << 5); R = (st >> 1) * 16 + swz / 64; C = (st & 1) * 32 + (swz % 64) / 2; }
__host__ __device__ __forceinline__ int perm32(int rho) { const int n = rho >> 4, i = rho & 15; return 8 * (i >> 2) + 4 * n + (i & 3); }

struct Unit { int pm, pn; };
struct Gemm { const bf16_t* A; const bf16_t* Bt; int M, N, K; };

struct StaticOrder {
    int nM, nN, nwg, G, c, wgm;
    __host__ __device__ void init(int M, int N, int G_, int c_, int wgm_ = WGM) { nM = M / BM; nN = N / BM; nwg = nM * nN; G = G_; c = c_; wgm = wgm_; }
    __host__ __device__ bool next(int i, Unit& u) const {
        const long L = (long)i * G + c; if (L >= nwg) return false;
        int wgid = (int)L; { const int q = nwg / NXCD, r = nwg % NXCD, xcd = wgid % NXCD, off = wgid / NXCD; wgid = (xcd < r ? xcd * (q + 1) : r * (q + 1) + (xcd - r) * q) + off; }
        const int nig = wgm * nN, gid = wgid / nig, fm = gid * wgm, gsz = (nM - fm) < wgm ? (nM - fm) : wgm;
        u.pm = fm + ((wgid % nig) % gsz); u.pn = (wgid % nig) / gsz; return true;
    }
    __device__ __forceinline__ void a_ready(const Unit&) const {}
    __device__ __forceinline__ void done(const Unit&) const {}
};
__device__ __forceinline__ unsigned cvt_pk_bf16(float lo, float hi) { unsigned r; asm volatile("v_cvt_pk_bf16_f32 %0, %1, %2" : "=v"(r) : "v"(lo), "v"(hi)); return r; }
struct EpiRoute {
    static constexpr bool PERM = true, AFTER_DRAIN = false;
    bf16_t* d0; bf16_t* d1; bf16_t* d2; float* gates;
    int ld0, ld1, ld2, t1, t2, t3;
    __device__ __forceinline__ void operator()(const f32x4 (&acc)[2][2][4][2], const Unit& u, int wr, int wc, int fr, int fq) const {
        const int row0 = u.pm * BM + wr * 64 + fr;
        if (u.pn >= t3) {
            if (wc == 0) {
#pragma unroll
                for (int ai = 0; ai < 2; ++ai)
#pragma unroll
                    for (int m = 0; m < 4; ++m) { float* rowp = gates + (size_t)(row0 + ai * HALF + m * 16) * 32 + 8 * fq;
                        *(f32x4*)(rowp) = acc[ai][0][m][0]; *(f32x4*)(rowp + 4) = acc[ai][0][m][1]; }
            }
            return;
        }
        bf16_t* base; int ldc, colt;
        if (u.pn < t1) { base = d0; ldc = ld0; colt = u.pn * BM; }
        else if (u.pn < t2) { base = d1; ldc = ld1; colt = (u.pn - t1) * BM; }
        else { base = d2; ldc = ld2; colt = (u.pn - t2) * BM; }
        const int col0 = colt + wc * 32 + 8 * fq;
#pragma unroll
        for (int ai = 0; ai < 2; ++ai)
#pragma unroll
            for (int m = 0; m < 4; ++m) { bf16_t* rowp = base + (size_t)(row0 + ai * HALF + m * 16) * ldc + col0;
#pragma unroll
                for (int bj = 0; bj < 2; ++bj) { const f32x4 v0 = acc[ai][bj][m][0], v1 = acc[ai][bj][m][1];
                    u32x4 w; w.x = cvt_pk_bf16(v0[0], v0[1]); w.y = cvt_pk_bf16(v0[2], v0[3]); w.z = cvt_pk_bf16(v1[0], v1[1]); w.w = cvt_pk_bf16(v1[2], v1[3]);
                    *(u32x4*)(rowp + bj * HALF) = w; } }
    }
};

constexpr int E_DFF = 5632, E_NUP = 11264;
__device__ __forceinline__ float dpp_ror1(float x) { return __builtin_bit_cast(float, __builtin_amdgcn_mov_dpp(__builtin_bit_cast(int, x), 0x121, 0xf, 0xf, true)); }
__device__ __forceinline__ float dpp_rol1(float x) { return __builtin_bit_cast(float, __builtin_amdgcn_mov_dpp(__builtin_bit_cast(int, x), 0x12F, 0xf, 0xf, true)); }
typedef unsigned u32x2 __attribute__((ext_vector_type(2)));
struct EpiGate {
    static constexpr bool PERM = true, AFTER_DRAIN = false;
    bf16_t* GA; bf16_t* EDGE; const float* cw; const float* cb;
    __device__ __forceinline__ void operator()(const f32x4 (&acc)[2][2][4][2], const Unit& u, int wr, int wc, int fr, int fq) const {
        const int rowb = u.pm * BM + wr * 64;
        f32x4 WT[2][8];
#pragma unroll
        for (int n = 0; n < 2; ++n) {
            const int ch0 = u.pn * 128 + wc * 32 + fq * 8 + n * 4;
            WT[n][0] = *(const f32x4*)(cw + ch0); WT[n][1] = *(const f32x4*)(cw + E_NUP + ch0); WT[n][2] = *(const f32x4*)(cw + 2 * E_NUP + ch0);
            WT[n][3] = *(const f32x4*)(cw + E_DFF + ch0); WT[n][4] = *(const f32x4*)(cw + E_NUP + E_DFF + ch0); WT[n][5] = *(const f32x4*)(cw + 2 * E_NUP + E_DFF + ch0);
            WT[n][6] = *(const f32x4*)(cb + ch0); WT[n][7] = *(const f32x4*)(cb + E_DFF + ch0);
        }
#pragma unroll
        for (int n = 0; n < 2; ++n) {
            const int ch0 = u.pn * 128 + wc * 32 + fq * 8 + n * 4;
            const f32x4 wg0 = WT[n][0], wg1 = WT[n][1], wg2 = WT[n][2], wu0 = WT[n][3], wu1 = WT[n][4], wu2 = WT[n][5], bg = WT[n][6], bu = WT[n][7];
#pragma unroll
            for (int ai = 0; ai < 2; ++ai) {
                const int blk = (rowb + ai * HALF) >> 6;
#pragma unroll
                for (int m = 0; m < 4; ++m) {
                    const f32x4 cg = acc[ai][0][m][n], cu = acc[ai][1][m][n];
                    float o[4];
#pragma unroll
                    for (int i = 0; i < 4; ++i) {
                        const float sgp = (m > 0 && fr == 15) ? acc[ai][0][m > 0 ? m - 1 : 0][n][i] : cg[i], sup = (m > 0 && fr == 15) ? acc[ai][1][m > 0 ? m - 1 : 0][n][i] : cu[i];
                        const float sgn = (m < 3 && fr == 0) ? acc[ai][0][m < 3 ? m + 1 : 3][n][i] : cg[i], sun = (m < 3 && fr == 0) ? acc[ai][1][m < 3 ? m + 1 : 3][n][i] : cu[i];
                        const float pg = dpp_ror1(sgp), pu = dpp_ror1(sup), ng = dpp_rol1(sgn), nu = dpp_rol1(sun);
                        const float g = wg0[i] * pg + wg1[i] * cg[i] + wg2[i] * ng + bg[i];
                        const float uu = wu0[i] * pu + wu1[i] * cu[i] + wu2[i] * nu + bu[i];
                        o[i] = g * __builtin_amdgcn_rcpf(1.f + __expf(-g)) * uu;
                    }
                    const bool edge = (m == 0 && fr == 0) || (m == 3 && fr == 15);
                    if (!edge) { u32x2 w; w.x = cvt_pk_bf16(o[0], o[1]); w.y = cvt_pk_bf16(o[2], o[3]); *(u32x2*)(GA + (size_t)(rowb + ai * HALF + m * 16 + fr) * E_DFF + ch0) = w; }
                    if (m == 0 && fr < 2) { bf16_t* ep = EDGE + ((size_t)blk * 4 + fr) * E_NUP + ch0;
                        u32x2 w; w.x = cvt_pk_bf16(cg[0], cg[1]); w.y = cvt_pk_bf16(cg[2], cg[3]); *(u32x2*)ep = w; w.x = cvt_pk_bf16(cu[0], cu[1]); w.y = cvt_pk_bf16(cu[2], cu[3]); *(u32x2*)(ep + E_DFF) = w; }
                    if (m == 3 && fr >= 14) { bf16_t* ep = EDGE + ((size_t)blk * 4 + 2 + (fr - 14)) * E_NUP + ch0;
                        u32x2 w; w.x = cvt_pk_bf16(cg[0], cg[1]); w.y = cvt_pk_bf16(cg[2], cg[3]); *(u32x2*)ep = w; w.x = cvt_pk_bf16(cu[0], cu[1]); w.y = cvt_pk_bf16(cu[2], cu[3]); *(u32x2*)(ep + E_DFF) = w; }
                }
            }
        }
    }
};
template <class Epi, class Sched, bool ALIGN_EPI = false, bool SP2 = false>
__device__ __forceinline__ void gemm_phase(PG8_LAS unsigned char* lds, const Gemm g, const Sched& S, const Epi& E) {
    int tid_ = threadIdx.x; asm volatile("" : "+v"(tid_));
    const int tid = tid_, wid = __builtin_amdgcn_readfirstlane(tid >> 6), lane = tid & 63, wr = wid >> 2, wc = wid & 3, fr = lane & 15, fq = lane >> 4;
    const int K = g.K, nt = K / BK;
    unsigned voffA[2], voffB[2];
#pragma unroll
    for (int i = 0; i < 2; ++i) { int R, C; stage_rc(tid * 16 + i * 8192, R, C); const int Rb = Epi::PERM ? ((R & ~31) + perm32(R & 31)) : R;
        voffA[i] = (unsigned)(R * K + C) * 2u; voffB[i] = (unsigned)(Rb * K + C) * 2u; }
    const size_t kstep = (size_t)(BK * 2);
    const size_t hstep = (size_t)HALF * K * 2;
    const size_t tstep = 2 * hstep;
    const unsigned ldsw = (unsigned)wid * 1024u;
    const int aoff = lds_byte(wr * 64 + fr, fq * 8), boff = lds_byte(wc * 32 + fr, fq * 8);
#define PG8_SA(b, h) (((b) * 2 + (h)) * HTB)
#define PG8_SB(b, h) ((4 + (b) * 2 + (h)) * HTB)
#define PG8_STAGE(bufoff, gbase, voff) do { _Pragma("unroll") for (int _i = 0; _i < 2; ++_i) \
        __builtin_amdgcn_global_load_lds((const unsigned*)((const char*)(gbase) + (voff)[_i]), (PG8_LAS unsigned*)(lds + (bufoff) + ldsw + _i * 8192), 16, 0, 0); } while (0)
#define PG8_LDA(dst, b, h) do { _Pragma("unroll") for (int m = 0; m < 4; ++m) _Pragma("unroll") for (int k = 0; k < 2; ++k) dst[m][k] = *(const PG8_LAS bf16x8*)(lds + PG8_SA(b, h) + aoff + m * 2048 + k * 1024); } while (0)
#define PG8_LDB(dst, b, h) do { _Pragma("unroll") for (int n = 0; n < 2; ++n) _Pragma("unroll") for (int k = 0; k < 2; ++k) dst[n][k] = *(const PG8_LAS bf16x8*)(lds + PG8_SB(b, h) + boff + n * 2048 + k * 1024); } while (0)
#define PG8_MMA(ai, bj, At, Bt) do { __builtin_amdgcn_s_setprio(1); _Pragma("unroll") for (int m = 0; m < 4; ++m) _Pragma("unroll") for (int n = 0; n < 2; ++n) _Pragma("unroll") for (int k = 0; k < 2; ++k) \
        acc[ai][bj][m][n] = __builtin_amdgcn_mfma_f32_16x16x32_bf16(Bt[n][k], At[m][k], acc[ai][bj][m][n], 0, 0, 0); __builtin_amdgcn_s_setprio(0); } while (0)
#define PG8_WAIT_V(n) asm volatile("s_waitcnt vmcnt(" #n ")" ::: "memory")
#define PG8_WAIT_L(n) asm volatile("s_waitcnt lgkmcnt(" #n ")" ::: "memory")
#define PG8_BAR __builtin_amdgcn_s_barrier()
#define PG8_SCHED __builtin_amdgcn_sched_barrier(0)
    Unit cur, nxt; int ui = 0;
    if (!S.next(0, cur)) return;
    f32x4 acc[2][2][4][2];
#pragma unroll
    for (int a = 0; a < 2; ++a)
#pragma unroll
        for (int b = 0; b < 2; ++b)
#pragma unroll
            for (int m = 0; m < 4; ++m)
#pragma unroll
                for (int n = 0; n < 2; ++n) acc[a][b][m][n] = (f32x4){0.f, 0.f, 0.f, 0.f};
    bf16x8 At[4][2], B0[2][2], B1[2][2];
    const char* cA = (const char*)g.A + (size_t)cur.pm * tstep; const char* cB = (const char*)g.Bt + (size_t)cur.pn * tstep;
    S.a_ready(cur);
    if constexpr (SP2) {
        PG8_STAGE(PG8_SB(0, 0), cB, voffB); PG8_STAGE(PG8_SB(0, 1), cB + hstep, voffB); PG8_STAGE(PG8_SA(0, 0), cA, voffA); PG8_STAGE(PG8_SA(0, 1), cA + hstep, voffA);
        if (wr == 1) PG8_BAR;
        PG8_WAIT_V(2); PG8_BAR;
        PG8_STAGE(PG8_SB(1, 0), cB + kstep, voffB); PG8_STAGE(PG8_SA(1, 0), cA + kstep, voffA); PG8_STAGE(PG8_SB(1, 1), cB + hstep + kstep, voffB);
        PG8_WAIT_V(6); PG8_BAR;
    } else {
        PG8_STAGE(PG8_SB(0, 0), cB, voffB); PG8_STAGE(PG8_SA(0, 0), cA, voffA); PG8_STAGE(PG8_SB(0, 1), cB + hstep, voffB); PG8_STAGE(PG8_SA(0, 1), cA + hstep, voffA);
        if (wr == 1) PG8_BAR;
        PG8_WAIT_V(4); PG8_BAR;
        PG8_STAGE(PG8_SB(1, 0), cB + kstep, voffB); PG8_STAGE(PG8_SA(1, 0), cA + kstep, voffA); PG8_STAGE(PG8_SB(1, 1), cB + hstep + kstep, voffB);
        PG8_WAIT_V(6); PG8_BAR;
    }
    for (;;) {
        const bool has_next = S.next(ui + 1, nxt);
        const char* nA = has_next ? (const char*)g.A + (size_t)nxt.pm * tstep : cA; const char* nB = has_next ? (const char*)g.Bt + (size_t)nxt.pn * tstep : cB;
        for (int t = 0; t < nt; t += 2) {
            const bool last = (t == nt - 2);
            const char* a1 = cA + (size_t)(t + 1) * kstep;
            const char* a2 = last ? nA : cA + (size_t)(t + 2) * kstep; const char* b2 = last ? nB : cB + (size_t)(t + 2) * kstep;
            const char* a3 = a2 + kstep; const char* b3 = b2 + kstep;
            if (last && has_next) S.a_ready(nxt);
            if constexpr (SP2) {
            PG8_LDB(B0, 0, 0); PG8_LDB(B1, 0, 1); PG8_SCHED; PG8_LDA(At, 0, 0); PG8_STAGE(PG8_SA(1, 1), a1 + hstep, voffA);
            PG8_WAIT_V(8); PG8_WAIT_L(0); PG8_BAR; PG8_MMA(0, 0, At, B0); PG8_MMA(0, 1, At, B1); PG8_BAR; PG8_SCHED;
            PG8_LDA(At, 0, 1); PG8_STAGE(PG8_SB(0, 0), b2, voffB); PG8_STAGE(PG8_SB(0, 1), b2 + hstep, voffB); PG8_STAGE(PG8_SA(0, 0), a2, voffA);
            PG8_WAIT_V(8); PG8_WAIT_L(0); PG8_BAR; PG8_MMA(1, 0, At, B0); PG8_MMA(1, 1, At, B1); PG8_BAR; PG8_SCHED;
            PG8_LDB(B0, 1, 0); PG8_LDB(B1, 1, 1); PG8_SCHED; PG8_LDA(At, 1, 0); PG8_STAGE(PG8_SA(0, 1), a2 + hstep, voffA);
            PG8_WAIT_V(8); PG8_WAIT_L(0); PG8_BAR; PG8_MMA(0, 0, At, B0); PG8_MMA(0, 1, At, B1); PG8_BAR; PG8_SCHED;
            PG8_LDA(At, 1, 1); PG8_STAGE(PG8_SB(1, 0), b3, voffB); PG8_STAGE(PG8_SB(1, 1), b3 + hstep, voffB); PG8_STAGE(PG8_SA(1, 0), a3, voffA);
            PG8_WAIT_V(8); PG8_WAIT_L(0); PG8_BAR; PG8_MMA(1, 0, At, B0); PG8_MMA(1, 1, At, B1); PG8_BAR; PG8_SCHED;
            } else {
            PG8_LDB(B0, 0, 0); PG8_SCHED; PG8_LDA(At, 0, 0); PG8_STAGE(PG8_SA(1, 1), a1 + hstep, voffA);
            PG8_WAIT_L(8); PG8_BAR; PG8_WAIT_L(0); PG8_MMA(0, 0, At, B0); PG8_BAR; PG8_SCHED;
            PG8_LDB(B1, 0, 1); PG8_STAGE(PG8_SB(0, 0), b2, voffB);
            PG8_BAR; PG8_WAIT_L(0); PG8_MMA(0, 1, At, B1); PG8_BAR;
            PG8_LDA(At, 0, 1); PG8_STAGE(PG8_SA(0, 0), a2, voffA);
            PG8_BAR; PG8_WAIT_L(0); PG8_MMA(1, 0, At, B0); PG8_BAR; PG8_SCHED;
            PG8_STAGE(PG8_SB(0, 1), b2 + hstep, voffB);
            PG8_WAIT_V(6); PG8_BAR; PG8_MMA(1, 1, At, B1); PG8_BAR;
            PG8_LDB(B0, 1, 0); PG8_SCHED; PG8_LDA(At, 1, 0); PG8_STAGE(PG8_SA(0, 1), a2 + hstep, voffA);
            PG8_WAIT_L(8); PG8_BAR; PG8_WAIT_L(0); PG8_MMA(0, 0, At, B0); PG8_BAR; PG8_SCHED;
            PG8_LDB(B1, 1, 1); PG8_STAGE(PG8_SB(1, 0), b3, voffB);
            PG8_BAR; PG8_WAIT_L(0); PG8_MMA(0, 1, At, B1); PG8_BAR;
            PG8_LDA(At, 1, 1); PG8_STAGE(PG8_SA(1, 0), a3, voffA);
            PG8_BAR; PG8_WAIT_L(0); PG8_MMA(1, 0, At, B0); PG8_BAR; PG8_SCHED;
            PG8_STAGE(PG8_SB(1, 1), b3 + hstep, voffB);
            PG8_WAIT_V(6); PG8_BAR; PG8_MMA(1, 1, At, B1); PG8_BAR;
            }
        }
        if constexpr (ALIGN_EPI) { if (wr == 0) PG8_BAR; }
        if constexpr (!Epi::AFTER_DRAIN) { E(acc, cur, wr, wc, fr, fq); S.done(cur); }
        if (!has_next) break;
#pragma unroll
        for (int a = 0; a < 2; ++a)
#pragma unroll
            for (int b = 0; b < 2; ++b)
#pragma unroll
                for (int m = 0; m < 4; ++m)
#pragma unroll
                    for (int n = 0; n < 2; ++n) acc[a][b][m][n] = (f32x4){0.f, 0.f, 0.f, 0.f};
        cur = nxt; cA = nA; cB = nB; ++ui;
        if constexpr (ALIGN_EPI) { if (wr == 1) PG8_BAR; }
    }
    PG8_WAIT_V(0);
    if constexpr (!ALIGN_EPI) { if (wr == 0) PG8_BAR; }
    PG8_BAR;
    if constexpr (Epi::AFTER_DRAIN) { E.fused(acc, cur, wr, wc, fr, fq, lds, wid, lane); S.done(cur); }
#undef PG8_SA
#undef PG8_SB
#undef PG8_STAGE
#undef PG8_LDA
#undef PG8_LDB
#undef PG8_MMA
#undef PG8_WAIT_V
#undef PG8_WAIT_L
#undef PG8_BAR
#undef PG8_SCHED
}
}
#define LAS __attribute__((address_space(3)))
#define XB_TMO      128
#define XB_XCNT(j)  (256  + 64 * (j))
#define XB_XSUB(j)  (1280 + 64 * (j))
#define XB_XGEN(j)  (2304 + 64 * (j))
#define XB_TOP      3328
#define XB_TOPGEN   3392
#define XCD_BAR_WORDS 3456
#define XB_SPIN_CAP (1u << 18)

__device__ __forceinline__ unsigned xb_ld(unsigned* p)              { return __hip_atomic_load(p, __ATOMIC_RELAXED, __HIP_MEMORY_SCOPE_AGENT); }
__device__ __forceinline__ unsigned xb_add(unsigned* p, unsigned v) { return __hip_atomic_fetch_add(p, v, __ATOMIC_RELAXED, __HIP_MEMORY_SCOPE_AGENT); }
__device__ __forceinline__ unsigned xb_xcc_id() { return (unsigned)__builtin_amdgcn_s_getreg((3 << 11) | 20) & 0xFu; }
#define XB_SPIN(cond, bar) do { unsigned _sp = 0; while (cond) { __builtin_amdgcn_s_sleep(1); \
    if ((++_sp & 255u) == 0u) { if (xb_ld(&(bar)[XB_TMO])) break; if (_sp > XB_SPIN_CAP) { atomicAdd(&(bar)[XB_TMO], 1u); break; } } } } while (0)

struct XcdBarrier {
    unsigned* bar; unsigned x;
    volatile LAS unsigned* st;
};

__device__ __forceinline__ XcdBarrier xcd_barrier_post(unsigned* bar, volatile LAS unsigned* st) {
    XcdBarrier b; b.bar = bar; b.x = xb_xcc_id(); b.st = st;
    if (threadIdx.x == 0) (void)xb_add(&bar[XB_XCNT(b.x)], 1u);
    return b;
}
__device__ __forceinline__ void xcd_barrier_complete(unsigned* bar, unsigned x, unsigned& nloc, unsigned& nx) {
    const unsigned G = gridDim.x * gridDim.y * gridDim.z;
    unsigned sum, cnt, mine, sp = 0u;
    for (;;) {
        sum = 0u; cnt = 0u; mine = 0u;
#pragma unroll
        for (unsigned j = 0; j < 16; ++j) { const unsigned c = xb_ld(&bar[XB_XCNT(j)]); sum += c; cnt += (c > 0u) ? 1u : 0u; mine = (j == x) ? c : mine; }
        if (sum == G) break;
        __builtin_amdgcn_s_sleep(1);
        if ((++sp & 255u) == 0u) { if (xb_ld(&bar[XB_TMO])) break; if (sp > XB_SPIN_CAP) { atomicAdd(&bar[XB_TMO], 1u); break; } }
    }
    nloc = mine > 0u ? mine : 1u; nx = cnt > 0u ? cnt : 1u;
}

__device__ __forceinline__ void xcd_barrier(const XcdBarrier& b) {
    asm volatile("s_waitcnt vmcnt(0)" ::: "memory");
    __syncthreads();
    if (threadIdx.x == 0) {
        unsigned* bar = b.bar;
        __builtin_amdgcn_s_waitcnt(0);
        unsigned nloc = b.st[0], nx = b.st[1];
        if (nloc == 0u) { xcd_barrier_complete(bar, b.x, nloc, nx); b.st[0] = nloc; b.st[1] = nx; }
        const unsigned old = xb_add(&bar[XB_XSUB(b.x)], 1u);
        const unsigned gen = old / nloc;
        if (old + 1u == (gen + 1u) * nloc) {
            __builtin_amdgcn_fence(__ATOMIC_RELEASE, "agent");
            asm volatile("s_waitcnt vmcnt(0)" ::: "memory");
            const unsigned og = xb_add(&bar[XB_TOP], 1u);
            const unsigned tg = og / nx;
            if (og + 1u == (tg + 1u) * nx) xb_add(&bar[XB_TOPGEN], 1u);
            else XB_SPIN(xb_ld(&bar[XB_TOPGEN]) == tg, bar);
            __builtin_amdgcn_fence(__ATOMIC_ACQUIRE, "agent");
            xb_add(&bar[XB_XGEN(b.x)], 1u);
            asm volatile("s_waitcnt vmcnt(0)" ::: "memory");
        } else {
            XB_SPIN(xb_ld(&bar[XB_XGEN(b.x)]) == gen, bar);
            __builtin_amdgcn_fence(__ATOMIC_ACQUIRE, "agent");
            asm volatile("s_waitcnt vmcnt(0)" ::: "memory");
        }
    }
    __syncthreads();
}
constexpr int DM = 2048, DEPTH = 4, NH = 8, HD = 128, DFF = 5632, NUP = 2 * DFF;
constexpr int INC = 7200, INP = 7424;
constexpr int TG = 65536, NGRP = 1, THALF = 32768;
#define EPS (oc(1e-6f))
constexpr int NWAVES = 8, NTHR = 512;
constexpr size_t MiB = 1u << 20;
constexpr size_t WS_CTL = 0, CTL_ZERO_BYTES = 64 * 1024;
constexpr size_t WS_BIAS = 512 * 1024;
constexpr size_t WS_WIN = 1 * MiB, WS_WOUT = 30 * MiB, WS_WUP = 38 * MiB, WS_WDN = 82 * MiB;
constexpr size_t WS_H = 104 * MiB;
constexpr size_t WS_QKVA = 360 * MiB;
constexpr size_t WS_QKVD = 744 * MiB;
constexpr size_t WS_Z = 1128 * MiB;
constexpr size_t WS_GATES = 1256 * MiB;
constexpr size_t WS_BG = 1264 * MiB;
constexpr size_t WS_QKVN = 1272 * MiB;
constexpr size_t WS_OF = 1656 * MiB, WS_OB = 1784 * MiB;
constexpr size_t WS_MIX = WS_QKVN;
constexpr size_t WS_MIXED = WS_QKVA;
constexpr size_t WS_ATTP = WS_QKVD;
constexpr size_t WS_ATTML = 1912 * MiB;
constexpr size_t WS_GACT = 360 * MiB;
constexpr size_t WS_EDGE = 1128 * MiB;
constexpr size_t WS_F = 1272 * MiB;
__host__ __device__ __forceinline__ constexpr size_t ws_h(int) { return WS_H; }
constexpr size_t WS_SC = 1924 * MiB;
constexpr size_t WS_END = 1936 * MiB;
constexpr int CW_BAR = 1024;
constexpr int CW_ATTQ = 8192;
constexpr int RING_BYTES = 131072, LDS_BYTES = 163840, MISC_OFF = LDS_BYTES - 512;

#define GAS __attribute__((address_space(1)))
typedef unsigned short bf16;
typedef unsigned v4u __attribute__((ext_vector_type(4)));
typedef unsigned v2u __attribute__((ext_vector_type(2)));
typedef float f32x4 __attribute__((ext_vector_type(4)));
#define DI __device__ __forceinline__
DI int otid() { int t = threadIdx.x; asm volatile("" : "+v"(t)); return t; }
DI int obid() { int b = blockIdx.x; asm volatile("" : "+s"(b)); return b; }
DI float oc(float c) { asm volatile("" : "+v"(c)); return c; }
DI float shx(float v, int m) { return __builtin_bit_cast(float, __builtin_amdgcn_ds_bpermute(((otid() & 63) ^ m) << 2, __builtin_bit_cast(int, v))); }
DI void dma16(const void* g, LAS void* l) {
    asm volatile("s_mov_b32 m0, %1\n\ts_nop 0\n\tglobal_load_lds_dwordx4 %0, off" :: "v"(g), "s"((unsigned)(size_t)l) : "memory", "m0"); }
DI void dma16s(const void* sbase, unsigned voff, LAS void* l) {
    asm volatile("s_mov_b32 m0, %2\n\ts_nop 0\n\tglobal_load_lds_dwordx4 %0, %1" :: "v"(voff), "s"(sbase), "s"((unsigned)(size_t)l) : "memory", "m0"); }
template <int N> DI float row_ror(float x) { return __builtin_bit_cast(float, __builtin_amdgcn_mov_dpp(__builtin_bit_cast(int, x), 0x120 + N, 0xf, 0xf, true)); }
DI float xr_max(float x) {
    auto s = __builtin_amdgcn_permlane16_swap(__builtin_bit_cast(unsigned, x), __builtin_bit_cast(unsigned, x), false, false);
    x = fmaxf(__builtin_bit_cast(float, s[0]), __builtin_bit_cast(float, s[1]));
    auto t = __builtin_amdgcn_permlane32_swap(__builtin_bit_cast(unsigned, x), __builtin_bit_cast(unsigned, x), false, false);
    return fmaxf(__builtin_bit_cast(float, t[0]), __builtin_bit_cast(float, t[1])); }
DI float xr_sum(float x) {
    auto s = __builtin_amdgcn_permlane16_swap(__builtin_bit_cast(unsigned, x), __builtin_bit_cast(unsigned, x), false, false);
    x = __builtin_bit_cast(float, s[0]) + __builtin_bit_cast(float, s[1]);
    auto t = __builtin_amdgcn_permlane32_swap(__builtin_bit_cast(unsigned, x), __builtin_bit_cast(unsigned, x), false, false);
    return __builtin_bit_cast(float, t[0]) + __builtin_bit_cast(float, t[1]); }
DI float bf2f(unsigned v) { return __uint_as_float(v << 16); }
DI float bflo(unsigned w) { return __uint_as_float(w << 16); }
DI float bfhi(unsigned w) { return __uint_as_float(w & 0xffff0000u); }
typedef __bf16 bf16x2v __attribute__((ext_vector_type(2)));
typedef float f32x2v __attribute__((ext_vector_type(2)));
DI unsigned cvtpk(float lo, float hi) { return __builtin_bit_cast(unsigned, __builtin_convertvector((f32x2v){lo, hi}, bf16x2v)); }
DI unsigned pk2(float lo, float hi) { return cvtpk(lo, hi); }
DI unsigned f2bf(float f) { return cvtpk(f, 0.f) & 0xffffu; }
DI float wave_sum(float v) {
#pragma unroll
    for (int o = 1; o < 64; o <<= 1) v += shx(v, o);
    return v;
}
DI float siluf(float x) { return x / (1.f + __expf(-x)); }
DI size_t grow(int, int r) { return (size_t)r; }
DI void seq_of(int r, int& s0, int& L) { if (r < 32768) { s0 = r & ~4095; L = 4096; } else { s0 = 32768 + ((r - 32768) & ~8191); L = 8192; } }

struct Args { const float* in[18]; float* out; unsigned char* ws; int s_lo, s_hi; };
typedef const __attribute__((address_space(4))) Args CArgs;

DI void ph_bias(const float* rel_bias, float* tab) {
    const int i = obid() * NTHR + otid();
    if (i < 3 * 129 * 8) {
        const int br = i / (129 * 8), h = (i / 129) & 7, j = i % 129 - 64, d = br == 0 ? 1 : (br == 1 ? 4 : 16);
        const int rel = j * d, n = rel < 0 ? -rel : rel, base = rel > 0 ? 16 : 0;
        const float nf = (float)(n > 1 ? n : 1);
        int large = 8 + (int)(__builtin_amdgcn_logf(nf * 0.125f) * oc(8.f / 7.f)); large = large < 15 ? large : 15;
        const int bucket = base + (n < 8 ? n : large);
        tab[i] = rel_bias[bucket * 8 + h];
    }
}
DI void transpose_item(const float* W, int K, int N, bf16* WT, LAS float* scr, int item, int lane, int nscale, float scale, bool gatemap = false) {
    const int nblk = N / 32, kb = item / nblk, nb = item % nblk, k0 = 64 * kb, n0 = 32 * nb;
    int d0 = n0; if (gatemap) { const int ch = n0 >= DFF ? n0 - DFF : n0; d0 = 256 * (ch >> 7) + (n0 >= DFF ? 128 : 0) + (ch & 127); }
    const float sc = (n0 < nscale) ? scale : 1.f;
#pragma unroll 8
    for (int i = 0; i < 32; ++i) { const int kk = 2 * i + (lane >> 5); scr[kk * 33 + (lane & 31)] = W[(size_t)(k0 + kk) * N + n0 + (lane & 31)] * sc; }
    asm volatile("s_waitcnt lgkmcnt(0)" ::: "memory");
    const int c = lane & 7;
#pragma unroll
    for (int j = 0; j < 4; ++j) { const int n = (lane >> 3) + 8 * j; const LAS float* s = scr + (8 * c) * 33 + n;
        v4u o; o.x = pk2(s[0 * 33], s[1 * 33]); o.y = pk2(s[2 * 33], s[3 * 33]); o.z = pk2(s[4 * 33], s[5 * 33]); o.w = pk2(s[6 * 33], s[7 * 33]);
        *(v4u*)(WT + (size_t)(d0 + n) * K + k0 + 8 * c) = o; }
    asm volatile("s_waitcnt lgkmcnt(0)" ::: "memory");
}
DI void ph_weights(CArgs& a, int l, LAS unsigned char* lds) {
    const int tid = otid(), lane = tid & 63, wave = __builtin_amdgcn_readfirstlane(tid >> 6);
    LAS float* scr = (LAS float*)(lds + wave * 16384);
    const int gw = obid() * NWAVES + wave, NGW = gridDim.x * NWAVES;
    const float* Win = a.in[4] + (size_t)l * DM * INC; const float* Wout = a.in[10] + (size_t)l * DM * DM;
    const float* Wup = a.in[13] + (size_t)l * DM * NUP; const float* Wdn = a.in[16] + (size_t)l * DFF * DM;
    bf16* Tin = (bf16*)(a.ws + WS_WIN); bf16* Tout = (bf16*)(a.ws + WS_WOUT); bf16* Tup = (bf16*)(a.ws + WS_WUP); bf16* Tdn = (bf16*)(a.ws + WS_WDN);
    constexpr int I_IN = (DM / 64) * (INC / 32), I_OUT = (DM / 64) * (DM / 32), I_UP = (DM / 64) * (NUP / 32), I_DN = (DFF / 64) * (DM / 32);
    for (int it = gw; it < I_IN + I_OUT + I_UP + I_DN; it += NGW) {
        int r = it;
        if (r < I_IN) { transpose_item(Win, DM, INC, Tin, scr, r, lane, 1024, oc(0.08838834764831845f)); continue; } r -= I_IN;
        if (r < I_OUT) { transpose_item(Wout, DM, DM, Tout, scr, r, lane, 0, 1.f); continue; } r -= I_OUT;
        if (r < I_UP) { transpose_item(Wup, DM, NUP, Tup, scr, r, lane, 0, 1.f, true); continue; } r -= I_UP;
        transpose_item(Wdn, DFF, DM, Tdn, scr, r, lane, 0, 1.f);
    }
    v4u* z = (v4u*)(Tin + (size_t)INC * DM); const int nz = (INP - INC) * DM / 8;
    const unsigned z0 = (unsigned)otid() >> 31;
    for (int i = obid() * NTHR + tid; i < nz; i += gridDim.x * NTHR) z[i] = (v4u){z0, z0, z0, z0};
}
DI void load_xrow(CArgs& a, int l, size_t R, int lane, f32x4 (&v)[8]) {
    if (l == 0) { const f32x4* x = (const f32x4*)((int)R < 32768 ? a.in[0] + R * DM : a.in[1] + (R - 32768) * DM);
#pragma unroll
        for (int j = 0; j < 8; ++j) v[j] = x[lane + 64 * j]; }
    else { const v2u* x = (const v2u*)(a.out + R * DM);
#pragma unroll
        for (int j = 0; j < 8; ++j) { const v2u w = x[lane + 64 * j]; v[j] = (f32x4){bflo(w.x), bfhi(w.x), bflo(w.y), bfhi(w.y)}; } }
}
DI float sumsq8(const f32x4 (&v)[8]) { float s = 0.f;
#pragma unroll
    for (int j = 0; j < 8; ++j) s += (v[j].x * v[j].x + v[j].y * v[j].y) + (v[j].z * v[j].z + v[j].w * v[j].w);
    return s; }
DI void cvt_row(const v2u (&w)[8], f32x4 (&v)[8]) {
#pragma unroll
    for (int j = 0; j < 8; ++j) v[j] = (f32x4){bflo(w[j].x), bfhi(w[j].x), bflo(w[j].y), bfhi(w[j].y)}; }
DI void ld_row_bf16(const bf16* rowp, int lane, v2u (&w)[8]) { const v2u* p = (const v2u*)rowp;
#pragma unroll
    for (int j = 0; j < 8; ++j) w[j] = __builtin_nontemporal_load(p + lane + 64 * j); }
DI void st_row_bf16(bf16* rowp, int lane, const f32x4 (&v)[8], float sc, const f32x4* gain) { v2u* o = (v2u*)rowp;
#pragma unroll
    for (int j = 0; j < 8; ++j) { const f32x4 gg = gain[lane + 64 * j]; v2u w; w.x = cvtpk(v[j].x * sc * gg.x, v[j].y * sc * gg.y); w.y = cvtpk(v[j].z * sc * gg.z, v[j].w * sc * gg.w); o[lane + 64 * j] = w; } }
DI void ph_prenorm(CArgs& a, int l, int g) {
    const int lane = otid() & 63, wave = __builtin_amdgcn_readfirstlane(otid() >> 6), gw = obid() * NWAVES + wave, NGW = gridDim.x * NWAVES;
    const f32x4* gain = (const f32x4*)(a.in[3] + (size_t)l * DM); bf16* H = (bf16*)(a.ws + ws_h(g));
    for (int r = gw; r < TG; r += 2 * NGW) {
        const int r1 = r + NGW;
        f32x4 va[8], vb[8]; load_xrow(a, l, grow(g, r), lane, va); load_xrow(a, l, grow(g, r1), lane, vb);
        st_row_bf16(H + (size_t)r * DM, lane, va, rsqrtf(wave_sum(sumsq8(va)) * (1.f / DM) + EPS), gain);
        st_row_bf16(H + (size_t)r1 * DM, lane, vb, rsqrtf(wave_sum(sumsq8(vb)) * (1.f / DM) + EPS), gain);
    }
}
template <int PV> DI void postmix_row(CArgs& a, int g, int r, size_t R, int lane, const v2u (&mw)[8], f32x4 (&x)[8], const f32x4* g1, const f32x4* g2) {
    f32x4 v[8]; cvt_row(mw, v);
    const float rinv = rsqrtf(wave_sum(sumsq8(v)) * (1.f / DM) + EPS);
    v2u* xo = PV ? (v2u*)((bf16*)(a.ws + WS_QKVN) + R * DM) : (v2u*)(a.out + R * DM);
#pragma unroll
    for (int j = 0; j < 8; ++j) { const f32x4 gg = g1[lane + 64 * j]; x[j] = x[j] + v[j] * rinv * gg; v2u w; w.x = cvtpk(x[j].x, x[j].y); w.y = cvtpk(x[j].z, x[j].w); xo[lane + 64 * j] = w; }
    st_row_bf16((bf16*)(a.ws + (PV ? WS_QKVD : ws_h(g))) + (size_t)r * DM, lane, x, rsqrtf(wave_sum(sumsq8(x)) * (1.f / DM) + EPS), g2);
}
template <int PV> DI void ph_postmix(CArgs& a, int l, int g) {
    const int lane = otid() & 63, wave = __builtin_amdgcn_readfirstlane(otid() >> 6), gw = obid() * NWAVES + wave, NGW = gridDim.x * NWAVES;
    const f32x4* g1 = (const f32x4*)(a.in[11] + (size_t)l * DM); const f32x4* g2 = (const f32x4*)(a.in[12] + (size_t)l * DM);
    const bf16* MX = (const bf16*)(a.ws + WS_MIXED);
    for (int rr = gw; rr < TG; rr += 2 * NGW) {
        const int r = TG - 1 - rr, r1 = r - NGW; const size_t R = grow(g, r), R1 = grow(g, r1);
        v2u ma[8], mb[8]; f32x4 xa[8], xb[8];
        ld_row_bf16(MX + (size_t)r * DM, lane, ma); load_xrow(a, l, R, lane, xa); ld_row_bf16(MX + (size_t)r1 * DM, lane, mb); load_xrow(a, l, R1, lane, xb);
        postmix_row<PV>(a, g, r, R, lane, ma, xa, g1, g2); postmix_row<PV>(a, g, r1, R1, lane, mb, xb, g1, g2);
    }
}
template <int PV> DI void postffn_row(CArgs& a, int l, int g, int r, size_t R, int lane, const v2u (&fw)[8], const v2u (&xw)[8], const f32x4* g1) {
    f32x4 v[8], x[8]; cvt_row(fw, v); cvt_row(xw, x);
    const float rinv = rsqrtf(wave_sum(sumsq8(v)) * (1.f / DM) + EPS);
#pragma unroll
    for (int j = 0; j < 8; ++j) { const f32x4 gg = g1[lane + 64 * j]; v[j] = x[j] + v[j] * rinv * gg; }
    if (l == DEPTH - 1) { f32x4* xo = PV ? (f32x4*)((float*)(a.ws + WS_QKVA) + R * DM) : (f32x4*)(a.out + R * DM);
#pragma unroll
        for (int j = 0; j < 8; ++j) xo[lane + 64 * j] = v[j]; }
    else { v2u* xo = PV ? (v2u*)((bf16*)(a.ws + WS_QKVA) + R * DM) : (v2u*)(a.out + R * DM);
#pragma unroll
        for (int j = 0; j < 8; ++j) { v2u w; w.x = cvtpk(v[j].x, v[j].y); w.y = cvtpk(v[j].z, v[j].w); xo[lane + 64 * j] = w; }
        st_row_bf16((bf16*)(a.ws + (PV ? WS_QKVD : ws_h(g))) + (size_t)r * DM, lane, v, rsqrtf(wave_sum(sumsq8(v)) * (1.f / DM) + EPS), (const f32x4*)(a.in[3] + (size_t)(l + 1) * DM)); }
}
template <int PV> DI void ph_postffn(CArgs& a, int l, int g) {
    const int lane = otid() & 63, wave = __builtin_amdgcn_readfirstlane(otid() >> 6), gw = obid() * NWAVES + wave, NGW = gridDim.x * NWAVES;
    const f32x4* g1 = (const f32x4*)(a.in[17] + (size_t)l * DM); const bf16* FB = (const bf16*)(a.ws + WS_F);
    for (int rr = gw; rr < TG; rr += 4 * NGW) {
        const int r = TG - 1 - rr, r1 = r - NGW, r2 = r - 2 * NGW, r3 = r - 3 * NGW; const size_t R = grow(g, r), R1 = grow(g, r1), R2 = grow(g, r2), R3 = grow(g, r3);
        v2u fa[8], fb[8], fc[8], fd[8], xa[8], xb[8], xc[8], xd[8];
        ld_row_bf16(FB + (size_t)r * DM, lane, fa); ld_row_bf16((const bf16*)(a.out + R * DM), lane, xa); ld_row_bf16(FB + (size_t)r1 * DM, lane, fb); ld_row_bf16((const bf16*)(a.out + R1 * DM), lane, xb);
        ld_row_bf16(FB + (size_t)r2 * DM, lane, fc); ld_row_bf16((const bf16*)(a.out + R2 * DM), lane, xc); ld_row_bf16(FB + (size_t)r3 * DM, lane, fd); ld_row_bf16((const bf16*)(a.out + R3 * DM), lane, xd);
        postffn_row<PV>(a, l, g, r, R, lane, fa, xa, g1); postffn_row<PV>(a, l, g, r1, R1, lane, fb, xb, g1); postffn_row<PV>(a, l, g, r2, R2, lane, fc, xc, g1); postffn_row<PV>(a, l, g, r3, R3, lane, fd, xd, g1);
    }
}
DI void ph_attn_simple(CArgs& a, int l) {
    const int lane = otid() & 63, wave = __builtin_amdgcn_readfirstlane(otid() >> 6), gw = obid() * NWAVES + wave, NGW = gridDim.x * NWAVES;
    const int ks = lane >> 4, dg = lane & 15;
    const bf16* QA = (const bf16*)(a.ws + WS_QKVA); bf16* MIX = (bf16*)(a.ws + WS_MIX);
    const float* tab = (const float*)(a.ws + WS_BIAS); const float* gain = a.in[8] + (size_t)l * HD;
    float gn[8];
#pragma unroll
    for (int i = 0; i < 8; ++i) gn[i] = gain[dg * 8 + i];
    for (int task = gw; task < TG * NH; task += NGW) {
        const int r = task >> 3, h = task & 7; int s0, L; seq_of(r, s0, L); const int p = r - s0;
        float q[8]; { const v4u w = *(const v4u*)(QA + (size_t)r * 3072 + h * HD + dg * 8);
            q[0] = bflo(w.x); q[1] = bfhi(w.x); q[2] = bflo(w.y); q[3] = bfhi(w.y); q[4] = bflo(w.z); q[5] = bfhi(w.z); q[6] = bflo(w.w); q[7] = bfhi(w.w); }
        float m = -1e30f, den = 0.f, o[8];
#pragma unroll
        for (int i = 0; i < 8; ++i) o[i] = 0.f;
        for (int br = 0; br < 3; ++br) {
            const int d = br == 0 ? 1 : (br == 1 ? 4 : 16);
            for (int it = 0; it < 33; ++it) {
                const int j = -64 + 4 * it + ks, pos = p + j * d;
                const bool valid = (j <= 64) && pos >= 0 && pos < L;
                float part = 0.f; const bf16* krow = QA + (size_t)(s0 + (valid ? pos : p)) * 3072 + h * HD + dg * 8;
                if (valid) { const v4u w = *(const v4u*)(krow + 1024);
                    part = q[0] * bflo(w.x) + q[1] * bfhi(w.x) + q[2] * bflo(w.y) + q[3] * bfhi(w.y) + q[4] * bflo(w.z) + q[5] * bfhi(w.z) + q[6] * bflo(w.w) + q[7] * bfhi(w.w); }
                part += shx(part, 1); part += shx(part, 2); part += shx(part, 4); part += shx(part, 8);
                if (valid) {
                    const float s = part + tab[(br * 8 + h) * 129 + (j + 64)];
                    const float mn = fmaxf(m, s), sc = __expf(m - mn), pw = __expf(s - mn);
                    const v4u w = *(const v4u*)(krow + 2048);
                    den = den * sc + pw; m = mn;
                    o[0] = o[0] * sc + pw * bflo(w.x); o[1] = o[1] * sc + pw * bfhi(w.x); o[2] = o[2] * sc + pw * bflo(w.y); o[3] = o[3] * sc + pw * bfhi(w.y);
                    o[4] = o[4] * sc + pw * bflo(w.z); o[5] = o[5] * sc + pw * bfhi(w.z); o[6] = o[6] * sc + pw * bflo(w.w); o[7] = o[7] * sc + pw * bfhi(w.w);
                }
            }
        }
        float ma = fmaxf(m, shx(m, 16)); ma = fmaxf(ma, shx(ma, 32));
        const float wg = __expf(m - ma);
        den *= wg; den += shx(den, 16); den += shx(den, 32);
        const float inv = 1.f / den; float ss = 0.f;
#pragma unroll
        for (int i = 0; i < 8; ++i) { float v = o[i] * wg; v += shx(v, 16); v += shx(v, 32); o[i] = v * inv; ss += o[i] * o[i]; }
        ss += shx(ss, 1); ss += shx(ss, 2); ss += shx(ss, 4); ss += shx(ss, 8);
        const float rinv = rsqrtf(ss * (1.f / HD) + EPS);
        if (ks == 0) { v4u w; w.x = pk2(o[0] * rinv * gn[0], o[1] * rinv * gn[1]); w.y = pk2(o[2] * rinv * gn[2], o[3] * rinv * gn[3]);
            w.z = pk2(o[4] * rinv * gn[4], o[5] * rinv * gn[5]); w.w = pk2(o[6] * rinv * gn[6], o[7] * rinv * gn[7]);
            *(v4u*)(MIX + (size_t)r * DM + h * HD + dg * 8) = w; }
    }
}

typedef short bf16x8 __attribute__((ext_vector_type(8)));
typedef short s16x4 __attribute__((ext_vector_type(4)));
typedef float f32x16 __attribute__((ext_vector_type(16)));
#define MFMA16(a, b, c) __builtin_amdgcn_mfma_f32_16x16x32_bf16((a), (b), (c), 0, 0, 0)
#define MFMA32(a, b, c) __builtin_amdgcn_mfma_f32_32x32x16_bf16((a), (b), (c), 0, 0, 0)
constexpr int VP = 272;
constexpr int ATT_WAVE_LDS = 32 * VP + 576;
DI void ph_attn_mfma(CArgs& a, LAS unsigned char* lds) {
    const int lane = otid() & 63, wave = __builtin_amdgcn_readfirstlane(otid() >> 6), gw = obid() * NWAVES + wave, NGW = gridDim.x * NWAVES;
    const int h5 = lane >> 5, ql = lane & 31;
    const bf16* QA = (const bf16*)(a.ws + WS_QKVA);
    const float* tab = (const float*)(a.ws + WS_BIAS);
    LAS unsigned char* vl = lds + wave * ATT_WAVE_LDS; LAS float* bl = (LAS float*)(vl + 32 * VP);
    const int i16 = lane & 15, q4 = i16 >> 2, p4 = i16 & 3, blk = (lane >> 4) & 1;
    for (int task = gw; task < 3 * 8192; task += NGW) {
        const int br = task >> 13, rem = task & 8191, h = rem >> 10, bidx = rem & 1023;
        const int d = br == 0 ? 1 : (br == 1 ? 4 : 16);
        int s0, L, within; if (bidx < 512) { s0 = (bidx >> 7) * 4096; L = 4096; within = bidx & 127; } else { s0 = 16384 + ((bidx - 512) >> 8) * 8192; L = 8192; within = (bidx - 512) & 255; }
        const int nsub = L / d, nqb = nsub >> 5, res = within / nqb, qb = within % nqb;
        for (int i = lane; i < 129; i += 64) bl[i] = tab[(br * 8 + h) * 129 + i];
        const bf16* base = QA + (size_t)(s0 + res) * 3072 + h * HD + 8 * h5;
        bf16x8 qf[8];
        { const bf16* qp = base + (size_t)(32 * qb + ql) * d * 3072;
#pragma unroll
          for (int ks = 0; ks < 8; ++ks) qf[ks] = *(const bf16x8*)(qp + 16 * ks); }
        f32x16 S[5];
#pragma unroll
        for (int kb = 0; kb < 5; ++kb) {
#pragma unroll
            for (int i = 0; i < 16; ++i) S[kb][i] = 0.f;
            const int mk0 = 32 * (qb + kb - 2);
            if (mk0 >= 0 && mk0 < nsub) {
                const bf16* kp = base + 1024 + (size_t)(mk0 + ql) * d * 3072;
                bf16x8 kf[8];
#pragma unroll
                for (int ks = 0; ks < 8; ++ks) kf[ks] = *(const bf16x8*)(kp + 16 * ks);
#pragma unroll
                for (int ks = 0; ks < 8; ++ks) S[kb] = MFMA32(kf[ks], qf[ks], S[kb]);
            }
        }
        float m = -1e30f;
#pragma unroll
        for (int kb = 0; kb < 5; ++kb) { const int mk0 = 32 * (qb + kb - 2); const bool bv = (mk0 >= 0 && mk0 < nsub);
#pragma unroll
            for (int i = 0; i < 16; ++i) { const int idx = 32 * kb + (i & 3) + 8 * (i >> 2) + 4 * h5 - ql; const bool ok = bv && idx >= 0 && idx <= 128;
                const float v = ok ? S[kb][i] + bl[ok ? idx : 0] : -1e30f; S[kb][i] = v; m = fmaxf(m, v); } }
        m = fmaxf(m, shx(m, 32));
        float den = 0.f;
#pragma unroll
        for (int kb = 0; kb < 5; ++kb)
#pragma unroll
            for (int i = 0; i < 16; ++i) { const float v = S[kb][i]; const float p = v > -1e29f ? __expf(v - m) : 0.f; S[kb][i] = p; den += p; }
        den += shx(den, 32);
        f32x16 O[4];
#pragma unroll
        for (int db = 0; db < 4; ++db)
#pragma unroll
            for (int i = 0; i < 16; ++i) O[db][i] = 0.f;
#pragma unroll
        for (int kb = 0; kb < 5; ++kb) {
            const int mk0 = 32 * (qb + kb - 2);
            if (mk0 >= 0 && mk0 < nsub) {
                v4u vr[8];
#pragma unroll
                for (int it = 0; it < 8; ++it) { const int row = 4 * it + (lane >> 4);
                    vr[it] = *(const v4u*)(QA + (size_t)(s0 + res + (size_t)(mk0 + row) * d) * 3072 + 2048 + h * HD + 8 * (lane & 15)); }
#pragma unroll
                for (int it = 0; it < 8; ++it) { const int row = 4 * it + (lane >> 4); *(LAS v4u*)(vl + row * VP + 16 * (lane & 15)) = vr[it]; }
#pragma unroll
                for (int s = 0; s < 2; ++s) {
                    v4u pw; pw.x = cvtpk(S[kb][8 * s + 0], S[kb][8 * s + 1]); pw.y = cvtpk(S[kb][8 * s + 2], S[kb][8 * s + 3]); pw.z = cvtpk(S[kb][8 * s + 4], S[kb][8 * s + 5]); pw.w = cvtpk(S[kb][8 * s + 6], S[kb][8 * s + 7]);
                    const bf16x8 pf = __builtin_bit_cast(bf16x8, pw);
#pragma unroll
                    for (int db = 0; db < 4; ++db) {
                        const s16x4 lo = __builtin_amdgcn_ds_read_tr16_b64_v4i16((LAS s16x4*)(vl + (16 * s + 4 * h5 + q4) * VP + (32 * db + 16 * blk + 4 * p4) * 2));
                        const s16x4 hi = __builtin_amdgcn_ds_read_tr16_b64_v4i16((LAS s16x4*)(vl + (16 * s + 8 + 4 * h5 + q4) * VP + (32 * db + 16 * blk + 4 * p4) * 2));
                        const bf16x8 vf = __builtin_shufflevector(lo, hi, 0, 1, 2, 3, 4, 5, 6, 7);
                        O[db] = MFMA32(vf, pf, O[db]);
                    }
                }
            }
        }
        const float inv = 1.f / den; const size_t row = (size_t)(s0 + res) + (size_t)(32 * qb + ql) * d;
        bf16* op = (bf16*)(a.ws + WS_ATTP) + ((size_t)br * TG + row) * 1024 + h * HD + 4 * h5;
#pragma unroll
        for (int db = 0; db < 4; ++db)
#pragma unroll
            for (int i4 = 0; i4 < 4; ++i4) { v2u w; w.x = cvtpk(O[db][4 * i4] * inv, O[db][4 * i4 + 1] * inv); w.y = cvtpk(O[db][4 * i4 + 2] * inv, O[db][4 * i4 + 3] * inv);
                *(v2u*)(op + 32 * db + 8 * i4) = w; }
        if (h5 == 0) { float* ml = (float*)(a.ws + WS_ATTML) + (((size_t)br * TG + row) * 8 + h) * 2; *(f32x2v*)ml = (f32x2v){m, den}; }
    }
}
DI bf16x8 pack8(const f32x4 lo, const f32x4 hi) { v4u p; p.x = cvtpk(lo[0], lo[1]); p.y = cvtpk(lo[2], lo[3]); p.z = cvtpk(hi[0], hi[1]); p.w = cvtpk(hi[2], hi[3]); return __builtin_bit_cast(bf16x8, p); }

struct AttnTile { int br, h, d, s0, nsub, res, mq0; };
DI AttnTile attn_decode(int tile) {
    AttnTile T; T.h = tile / 1536; int r = tile - T.h * 1536, L, within;
    if (r < 768) { const int sq = r / 96, rr = r - sq * 96; T.s0 = sq * 4096; L = 4096; T.br = rr >> 5; within = rr & 31; }
    else { r -= 768; const int sq = r / 192, rr = r - sq * 192; T.s0 = 32768 + sq * 8192; L = 8192; T.br = rr >> 6; within = rr & 63; }
    T.d = 1 << (2 * T.br);
    const int lgd = 2 * T.br, lgn = (L == 4096 ? 5 : 6) - lgd; T.nsub = L >> lgd; T.res = within >> lgn; T.mq0 = (within & ((1 << lgn) - 1)) << 7; return T;
}
constexpr int NATT = 3 * NH * (TG / 128);
template <int AV> DI void ph_attn2(CArgs& a, LAS unsigned char* lds, int l, int g, int qset = 0) {
    const int t = otid(), lane = t & 63, wave = __builtin_amdgcn_readfirstlane(t >> 6), ql = lane & 15, g4 = lane >> 4, q4 = ql >> 2, p4 = ql & 3;
    LAS unsigned char* Ki = lds; LAS unsigned char* Vi = lds + 65536;
    LAS float* bl0 = (LAS float*)(lds + 131072 + 1024); LAS float* bl12 = (LAS float*)(lds + 131072 + 4096 + 8 * 2048);
    LAS int* tqw = (LAS int*)(lds + 131072 + 512);
    int cur_h = -1;
    const unsigned dmaL0 = (unsigned)(((lane & 15) ^ (2 * g4)) * 16), dmaL1 = dmaL0 ^ 128u;
    unsigned kL[4], vL[8];
#pragma unroll
    for (int ks = 0; ks < 4; ++ks) kL[ks] = (unsigned)(ql * 256 + (((4 * ks + g4) ^ (2 * (ql & 7))) * 16));
    { const int vr = 4 * g4 + q4;
#pragma unroll
      for (int db = 0; db < 8; ++db) vL[db] = (unsigned)(vr * 256 + (((2 * db + (p4 >> 1)) ^ (2 * (vr & 7))) * 16) + 8 * (p4 & 1)); }
    const bf16* QA = (const bf16*)(a.ws + WS_QKVA); const float* tab = (const float*)(a.ws + WS_BIAS);
    unsigned* cntb = (unsigned*)(a.ws + WS_CTL) + CW_ATTQ + 64 * 8 * (qset * 8 + l * NGRP + g);
    const int xme = (int)(xb_xcc_id() & 7u);
    constexpr int NPAIR = NATT / 2, N8 = NPAIR / 8;
    int xq = 0;
#define ATT_FETCH(raw_, q_) do { q_ = xq < 8 ? xq : 7; raw_ = (int)__hip_atomic_fetch_add(cntb + 64 * ((xme + q_) & 7), 1u, __ATOMIC_RELAXED, __HIP_MEMORY_SCOPE_AGENT); } while (0)
    auto resolve = [&](int raw, int q) -> int {
        if (raw < N8) return ((xme + q) & 7) * N8 + raw;
        for (int qq = (xq > q + 1 ? xq : q + 1); qq < 8; ++qq) { const int i = (int)__hip_atomic_fetch_add(cntb + 64 * ((xme + qq) & 7), 1u, __ATOMIC_RELAXED, __HIP_MEMORY_SCOPE_AGENT); if (i < N8) { xq = qq; return ((xme + qq) & 7) * N8 + i; } }
        xq = 8; return NPAIR; };
    int nxt = 0, nxtq = 0;
    if (t == 0) { int r0_, q0_; ATT_FETCH(r0_, q0_); tqw[0] = resolve(r0_, q0_); ATT_FETCH(nxt, nxtq); }
    __syncthreads();
    int tile = 2 * tqw[0];
#define ATT_IMG(T_, sec_, cofs, dst, en) do { const unsigned char* gb_ = (const unsigned char*)(QA + (size_t)((T_).s0 + (T_).res) * 3072 + (T_).h * HD) + (cofs); \
        const int lgd_ = 2 * (T_).br, kofs_ = (T_).mq0 - 64 + ((sec_) ? 128 : 0), i0_ = ((sec_) ? 4 : 8) * wave; \
        if (!(((T_).mq0 < 64) || ((T_).mq0 + 192 > (T_).nsub))) { const unsigned lrow_ = (unsigned)(g4 * 6144) << lgd_; const unsigned l0_ = lrow_ + dmaL0, l1_ = lrow_ + dmaL1; \
            _Pragma("unroll") for (int u = 0; u < 8; ++u) { if (!(sec_) || u < 4) { const int i = i0_ + u; const unsigned ub_ = (unsigned)((kofs_ + 4 * i) * 6144) << lgd_; \
                if (en) dma16s(gb_, ((u & 1) ? l1_ : l0_) + ub_, (dst) + i * 1024); } } } \
        else { _Pragma("unroll") for (int u = 0; u < 8; ++u) { if (!(sec_) || u < 4) { const int i = i0_ + u; int m = kofs_ + 4 * i + g4; m = m < 0 ? 0 : (m > (T_).nsub - 1 ? (T_).nsub - 1 : m); \
                if (en) dma16s(gb_, ((unsigned)(m * 6144) << lgd_) + ((u & 1) ? dmaL1 : dmaL0), (dst) + i * 1024); } } } } while (0)
#define ATT_ISSUE_KQ(T_, qdst, sec_) do { ATT_IMG(T_, sec_, 2048, Ki, true); \
        const bf16* qp_ = QA + (size_t)((T_).s0 + (T_).res) * 3072 + (T_).h * HD + (size_t)((T_).mq0 + 16 * wave + ql) * (T_).d * 3072 + 8 * g4; \
        _Pragma("unroll") for (int ks = 0; ks < 4; ++ks) qdst[ks] = *(const bf16x8*)(qp_ + 32 * ks); } while (0)
    bf16x8 qf[4];
    if (tile < NATT) { const AttnTile T0 = attn_decode(tile); ATT_ISSUE_KQ(T0, qf, 0); }
    { unsigned* dmy = (unsigned*)(a.ws + WS_CTL + 768 * 1024) + t;
#pragma unroll
      for (int i = 0; i < 5; ++i) __builtin_nontemporal_store(0u, dmy + 512 * i); }
    while (tile < NATT) {
        const AttnTile T = attn_decode(tile);
        const int br = T.br, h = T.h, d = T.d, s0 = T.s0, nsub = T.nsub, res = T.res, mq0 = T.mq0;
        if (h != cur_h) { cur_h = h;
            for (int i = t; i < 3 * 4 * 192; i += NTHR) { const int b = i / 768, ii = i - b * 768, c = ii / 192, j = ii % 192, k = j + c - 16;
                (b == 0 ? bl0 : bl12 + (b - 1) * 768)[ii] = (k >= 0 && k < 129) ? tab[(b * 8 + h) * 129 + k] : -1e30f; } }
        const LAS float* bl = br == 0 ? bl0 : bl12 + (br - 1) * 768;
        const int sec = tile & 1;
        if (t == 0 && sec) tqw[1] = resolve(nxt, nxtq);
        const bf16* sbase = QA + (size_t)(s0 + res) * 3072 + h * HD;
        asm volatile("s_waitcnt vmcnt(5) lgkmcnt(0)" : "+v"(qf[0]), "+v"(qf[1]), "+v"(qf[2]), "+v"(qf[3]) :: "memory"); __builtin_amdgcn_s_barrier(); asm volatile("" ::: "memory");
        int nn2 = 0, nn2q = 0; if (t == 0 && sec) ATT_FETCH(nn2, nn2q);
        ATT_IMG(T, sec, 4096, Vi, !(AV & 16));
        const int ntile = sec ? 2 * tqw[1] : tile + 1;
        const int roff = sec ? 128 : 0;
        const bool edge_tile = (mq0 < 64) || (mq0 + 192 > nsub);
        const size_t qrow = (size_t)(s0 + res) + (size_t)(mq0 + 16 * wave + ql) * d;
        f32x4 S[9];
        bf16x8 ka[2][4];
#define LDK4(dst, kb) do { const unsigned rb_ = (unsigned)(((16 * (wave + (kb)) + roff) & 255) * 256); _Pragma("unroll") for (int ks = 0; ks < 4; ++ks) dst[ks] = *(const LAS bf16x8*)(Ki + rb_ + kL[ks]); } while (0)
        LDK4(ka[0], 0);
#pragma unroll
        for (int kb = 0; kb < 9; ++kb) {
            if (kb + 1 < 9) LDK4(ka[(kb + 1) & 1], kb + 1);
            __builtin_amdgcn_sched_barrier(0);
            S[kb] = (f32x4){0.f, 0.f, 0.f, 0.f};
#pragma unroll
            for (int ks = 0; ks < 4; ++ks) if (!(AV & 1)) S[kb] = MFMA16(ka[kb & 1][ks], qf[ks], S[kb]);
            __builtin_amdgcn_sched_barrier(0);
        }
#undef LDK4
        float mx = -1e30f;
        { const int a0 = 4 * g4 - ql + 16, c = a0 & 3;
          const LAS float* bc = bl + 192 * c + (a0 - c);
          if (!edge_tile) {
#pragma unroll
            for (int kb = 0; kb < 9; ++kb) {
              const f32x4 b4 = (AV & 8) ? (f32x4){0.f, 0.f, 0.f, 0.f} : *(const LAS f32x4*)(bc + 16 * kb);
#pragma unroll
              for (int i = 0; i < 4; ++i) { const float v = S[kb][i] + b4[i]; S[kb][i] = v; mx = fmaxf(mx, v); } }
          } else {
            const int lo = 64 - mq0 - 16 * wave - 4 * g4; const unsigned rng = (unsigned)(nsub - 1);
#pragma unroll
            for (int kb = 0; kb < 9; ++kb) {
              const f32x4 b4 = (AV & 8) ? (f32x4){0.f, 0.f, 0.f, 0.f} : *(const LAS f32x4*)(bc + 16 * kb);
#pragma unroll
              for (int i = 0; i < 4; ++i) { const float sb = S[kb][i] + b4[i]; const float v = ((unsigned)(16 * kb + i - lo) <= rng) ? sb : -1e30f; S[kb][i] = v; mx = fmaxf(mx, v); } }
          } }
        mx = xr_max(mx);
        float den = 0.f;
        { const float mxs = -mx * 1.44269504f;
#pragma unroll
          for (int kb = 0; kb < 9; ++kb)
#pragma unroll
            for (int i = 0; i < 4; ++i) { if (!(AV & 2)) { const float p = __builtin_amdgcn_exp2f(__builtin_fmaf(S[kb][i], 1.44269504f, mxs)); S[kb][i] = p; den += p; } else den += 1.f; } }
        den = xr_sum(den);
        asm volatile("s_waitcnt vmcnt(0) lgkmcnt(0)" ::: "memory"); __builtin_amdgcn_s_barrier(); asm volatile("" ::: "memory");
        if (!(AV & 16) && ntile < NATT) { const AttnTile Tn = attn_decode(ntile); ATT_ISSUE_KQ(Tn, qf, (ntile & 1)); }
        f32x4 O[8];
#pragma unroll
        for (int db = 0; db < 8; ++db) O[db] = (f32x4){0.f, 0.f, 0.f, 0.f};
        s16x4 va[2][16];
#define LDV16(dst, s) do { const unsigned blo_ = (unsigned)(((16 * (wave + 2 * (s)) + roff) & 255) * 256), bhi_ = (2 * (s) + 1 < 9) ? (unsigned)(((16 * (wave + 2 * (s) + 1) + roff) & 255) * 256) : blo_; \
            _Pragma("unroll") for (int db = 0; db < 8; ++db) { \
                dst[2 * db] = __builtin_amdgcn_ds_read_tr16_b64_v4i16((LAS s16x4*)(Vi + blo_ + vL[db])); \
                dst[2 * db + 1] = __builtin_amdgcn_ds_read_tr16_b64_v4i16((LAS s16x4*)(Vi + bhi_ + vL[db])); } } while (0)
        LDV16(va[0], 0);
#pragma unroll
        for (int s = 0; s < 5; ++s) {
            if (s + 1 < 5) LDV16(va[(s + 1) & 1], s + 1);
            __builtin_amdgcn_sched_barrier(0);
            const bf16x8 Pf = pack8(S[2 * s], (2 * s + 1 < 9) ? S[2 * s + 1] : (f32x4){0.f, 0.f, 0.f, 0.f});
#pragma unroll
            for (int db = 0; db < 8; ++db) if (!(AV & 4)) O[db] = MFMA16(__builtin_shufflevector(va[s & 1][2 * db], va[s & 1][2 * db + 1], 0, 1, 2, 3, 4, 5, 6, 7), Pf, O[db]);
            __builtin_amdgcn_sched_barrier(0);
        }
#undef LDV16
        const float inv = 1.f / den;
        { LAS unsigned char* st = lds + 131072 + 4096 + wave * 2048;
          const size_t qrow_s = (size_t)(s0 + res) + (size_t)(mq0 + 16 * wave + (lane >> 2)) * d;
          bf16* op = (bf16*)(a.ws + (AV ? WS_QKVN : WS_ATTP)) + ((size_t)br * TG + qrow_s) * 1024 + h * HD + (lane & 3) * 16;
#pragma unroll
          for (int hf = 0; hf < 2; ++hf) { if (AV & 32) { asm volatile("" :: "v"(O[4 * hf]), "v"(O[4 * hf + 1]), "v"(O[4 * hf + 2]), "v"(O[4 * hf + 3])); continue; }
#pragma unroll
              for (int db = 0; db < 4; ++db) { const f32x4 o = O[4 * hf + db]; *(LAS v2u*)(st + ql * 128 + (16 * db + 4 * g4) * 2) = (v2u){cvtpk(o[0] * inv, o[1] * inv), cvtpk(o[2] * inv, o[3] * inv)}; }
              const v4u w0 = *(const LAS v4u*)(st + (lane >> 2) * 128 + (lane & 3) * 32), w1 = *(const LAS v4u*)(st + (lane >> 2) * 128 + (lane & 3) * 32 + 16);
              *(v4u*)(op + 64 * hf) = w0; *(v4u*)(op + 64 * hf + 8) = w1;
          } }
        { float* ml = (float*)(a.ws + (AV ? WS_GATES : WS_ATTML)) + (((size_t)br * TG + qrow) * 8 + h) * 2; *(f32x2v*)ml = (f32x2v){mx, den}; }
        tile = ntile; if (sec) { nxt = nn2; nxtq = nn2q; }
    }
#undef ATT_ISSUE_KQ
#undef ATT_IMG
#undef ATT_FETCH
    asm volatile("s_waitcnt vmcnt(0) lgkmcnt(0)" ::: "memory"); __builtin_amdgcn_s_barrier(); asm volatile("" ::: "memory");
}
DI void ph_attn_merge(CArgs& a, int l) {
    const int lane = otid() & 63, wave = __builtin_amdgcn_readfirstlane(otid() >> 6), gw = obid() * NWAVES + wave, NGW = gridDim.x * NWAVES;
    const bf16* AP = (const bf16*)(a.ws + WS_ATTP); const float* ML = (const float*)(a.ws + WS_ATTML); bf16* MIX = (bf16*)(a.ws + WS_MIX);
    const float* gain = a.in[8] + (size_t)l * HD + (lane & 7) * 16;
    float gn[16];
#pragma unroll
    for (int i = 0; i < 16; ++i) gn[i] = gain[i];
    const int h = lane >> 3;
    for (int r0 = gw; r0 < TG; r0 += 2 * NGW) {
        v4u pw[2][3][2]; f32x2v mlv[2][3];
#pragma unroll
        for (int rr = 0; rr < 2; ++rr) { const int r = r0 + rr * NGW;
#pragma unroll
            for (int b = 0; b < 3; ++b) { mlv[rr][b] = *(const f32x2v*)(ML + (((size_t)b * TG + r) * 8 + h) * 2);
                pw[rr][b][0] = *(const v4u*)(AP + ((size_t)b * TG + r) * 1024 + lane * 16); pw[rr][b][1] = *(const v4u*)(AP + ((size_t)b * TG + r) * 1024 + lane * 16 + 8); } }
#pragma unroll
        for (int rr = 0; rr < 2; ++rr) { const int r = r0 + rr * NGW;
            const float ma = fmaxf(mlv[rr][0].x, fmaxf(mlv[rr][1].x, mlv[rr][2].x));
            float w[3], ws = 0.f;
#pragma unroll
            for (int b = 0; b < 3; ++b) { w[b] = __expf(mlv[rr][b].x - ma) * mlv[rr][b].y; ws += w[b]; }
            const float inv = 1.f / ws;
            float o[16];
#pragma unroll
            for (int i = 0; i < 16; ++i) o[i] = 0.f;
#pragma unroll
            for (int b = 0; b < 3; ++b) { const float wb = w[b] * inv;
#pragma unroll
                for (int hf = 0; hf < 2; ++hf) { const v4u f = pw[rr][b][hf]; const unsigned fw[4] = {f.x, f.y, f.z, f.w};
#pragma unroll
                    for (int k = 0; k < 4; ++k) { o[hf * 8 + 2 * k] += wb * bflo(fw[k]); o[hf * 8 + 2 * k + 1] += wb * bfhi(fw[k]); } } }
            float ss = 0.f;
#pragma unroll
            for (int i = 0; i < 16; ++i) ss += o[i] * o[i];
            ss += shx(ss, 1); ss += shx(ss, 2); ss += shx(ss, 4);
            const float rinv = rsqrtf(ss * (1.f / HD) + EPS);
            unsigned wv[8];
#pragma unroll
            for (int k = 0; k < 8; ++k) wv[k] = pk2(o[2 * k] * rinv * gn[2 * k], o[2 * k + 1] * rinv * gn[2 * k + 1]);
            *(v4u*)(MIX + (size_t)r * DM + lane * 16) = (v4u){wv[0], wv[1], wv[2], wv[3]};
            *(v4u*)(MIX + (size_t)r * DM + lane * 16 + 8) = (v4u){wv[4], wv[5], wv[6], wv[7]};
        }
    }
}
DI void ph_dn_prep(CArgs& a, int l) {
    const int lane = otid() & 63, wave = __builtin_amdgcn_readfirstlane(otid() >> 6), gw = obid() * NWAVES + wave, NGW = gridDim.x * NWAVES;
    const bf16* RAW = (const bf16*)(a.ws + WS_QKVD); bf16* QN = (bf16*)(a.ws + WS_QKVN);
    const float* cw = a.in[5] + (size_t)l * 3 * 3072;
    constexpr int RS = 32, NSTRIP = TG / RS;
    for (int task = gw; task < NSTRIP * 6; task += NGW) {
        const int strip = NSTRIP - 1 - task / 6, cgp = task % 6, c0 = cgp * 512 + lane * 8, which = c0 >> 10, r0 = strip * RS;
        int s0, L; seq_of(r0, s0, L);
        float w0[8], w1[8], w2[8];
#pragma unroll
        for (int i = 0; i < 8; ++i) { w0[i] = cw[c0 + i]; w1[i] = cw[3072 + c0 + i]; w2[i] = cw[6144 + c0 + i]; }
        const float qs = which == 0 ? oc(0.08838834764831845f) : 1.f;
        v4u prev = (v4u){0u, 0u, 0u, 0u}, cur;
        if (r0 > s0) prev = *(const v4u*)(RAW + (size_t)(r0 - 1) * 3072 + c0);
        cur = *(const v4u*)(RAW + (size_t)r0 * 3072 + c0);
        for (int rb = 0; rb < RS; rb += 8) {
            v4u nx[8];
#pragma unroll
            for (int k = 0; k < 8; ++k) { const int r = r0 + rb + k + 1; nx[k] = (r < s0 + L) ? *(const v4u*)(RAW + (size_t)r * 3072 + c0) : (v4u){0u, 0u, 0u, 0u}; }
#pragma unroll
            for (int k = 0; k < 8; ++k) {
                const unsigned a0[4] = {prev.x, prev.y, prev.z, prev.w}, a1[4] = {cur.x, cur.y, cur.z, cur.w}, a2[4] = {nx[k].x, nx[k].y, nx[k].z, nx[k].w};
                float y[8]; float ss = 0.f;
#pragma unroll
                for (int j = 0; j < 4; ++j) {
                    y[2 * j] = siluf(w0[2 * j] * bflo(a0[j]) + w1[2 * j] * bflo(a1[j]) + w2[2 * j] * bflo(a2[j]));
                    y[2 * j + 1] = siluf(w0[2 * j + 1] * bfhi(a0[j]) + w1[2 * j + 1] * bfhi(a1[j]) + w2[2 * j + 1] * bfhi(a2[j]));
                    ss += y[2 * j] * y[2 * j] + y[2 * j + 1] * y[2 * j + 1];
                }
                float sc = 1.f;
                if (which < 2) { ss += row_ror<8>(ss); ss += row_ror<4>(ss); ss += row_ror<2>(ss); ss += row_ror<1>(ss); sc = rsqrtf(ss + EPS) * qs; }
                *(v4u*)(QN + (size_t)(r0 + rb + k) * 3072 + c0) = (v4u){cvtpk(y[0] * sc, y[1] * sc), cvtpk(y[2] * sc, y[3] * sc), cvtpk(y[4] * sc, y[5] * sc), cvtpk(y[6] * sc, y[7] * sc)};
                prev = cur; cur = nx[k];
            }
        }
    }
    const float* GT = (const float*)(a.ws + WS_GATES); float* BG = (float*)(a.ws + WS_BG);
    const float* alog = a.in[6] + l * 16; const float* dtb = a.in[7] + l * 16;
    for (int i = obid() * NTHR + otid(); i < TG * 32; i += gridDim.x * NTHR) {
        const int c = i & 31; const float x = GT[i]; float y;
        if (c < 16) y = 1.f / (1.f + __expf(-x));
        else { const float t = x + dtb[c - 16]; const float sp = t > 20.f ? t : __builtin_amdgcn_logf(1.f + __expf(t)) * oc(0.69314718f); y = -__expf(alog[c - 16]) * sp; }
        BG[i] = y;
    }
}
DI void ph_dn_scan_simple(CArgs& a, LAS unsigned char* lds) {
    const int t = otid(), c = t & 127, kg = __builtin_amdgcn_readfirstlane(t >> 7);
    LAS float* kq = (LAS float*)lds;
    LAS float* red = (LAS float*)(lds + 2048);
    LAS float* red2 = (LAS float*)(lds + 2048 + 4096);
    const bf16* QN = (const bf16*)(a.ws + WS_QKVN); const float* BG = (const float*)(a.ws + WS_BG);
    for (int chain = obid(); chain < 96; chain += gridDim.x) {
        const int seq = chain >> 4, h = (chain >> 1) & 7, dir = chain & 1;
        const int s0 = seq < 4 ? seq * 4096 : 16384 + (seq - 4) * 8192, L = seq < 4 ? 4096 : 8192;
        bf16* O = (bf16*)(a.ws + (dir ? WS_OB : WS_OF));
        float S[32];
#pragma unroll
        for (int i = 0; i < 32; ++i) S[i] = 0.f;
        int row = s0 + (dir ? L - 1 : 0);
        float kq_r = 0.f, v_r, g_r, b_r;
        if (t < 256) kq_r = bf2f(QN[(size_t)row * 3072 + (t < 128 ? 1024 + h * HD + t : h * HD + (t - 128))]);
        v_r = bf2f(QN[(size_t)row * 3072 + 2048 + h * HD + c]); b_r = BG[(size_t)row * 32 + dir * 8 + h]; g_r = BG[(size_t)row * 32 + 16 + dir * 8 + h];
        int prow = row;
        for (int i = 0; i < L; ++i) {
            const int buf = i & 1; const int crow = row;
            if (t < 256) kq[buf * 256 + t] = kq_r;
            const float v = v_r, eg = __expf(g_r), beta = b_r;
            if (i + 1 < L) { row = s0 + (dir ? L - 2 - i : i + 1);
                if (t < 256) kq_r = bf2f(QN[(size_t)row * 3072 + (t < 128 ? 1024 + h * HD + t : h * HD + (t - 128))]);
                v_r = bf2f(QN[(size_t)row * 3072 + 2048 + h * HD + c]); b_r = BG[(size_t)row * 32 + dir * 8 + h]; g_r = BG[(size_t)row * 32 + 16 + dir * 8 + h]; }
            __syncthreads();
            if (i > 0 && kg == 0) { const LAS float* rr = red2 + (buf ^ 1) * 512; O[(size_t)prow * 1024 + h * HD + c] = (bf16)f2bf(rr[c] + rr[128 + c] + rr[256 + c] + rr[384 + c]); }
            const LAS float* kk = kq + buf * 256 + kg * 32; const LAS float* qq = kq + buf * 256 + 128 + kg * 32;
            float part = 0.f;
#pragma unroll
            for (int j = 0; j < 32; ++j) { S[j] *= eg; part += kk[j] * S[j]; }
            red[buf * 512 + kg * 128 + c] = part;
            __syncthreads();
            const LAS float* rr = red + buf * 512; const float tot = rr[c] + rr[128 + c] + rr[256 + c] + rr[384 + c];
            const float vn = beta * (v - tot); float op = 0.f;
#pragma unroll
            for (int j = 0; j < 32; ++j) { S[j] += kk[j] * vn; op += qq[j] * S[j]; }
            red2[buf * 512 + kg * 128 + c] = op;
            prow = crow;
        }
        __syncthreads();
        if (kg == 0) { const LAS float* rr = red2 + ((L - 1) & 1) * 512; O[(size_t)prow * 1024 + h * HD + c] = (bf16)f2bf(rr[c] + rr[128 + c] + rr[256 + c] + rr[384 + c]); }
        __syncthreads();
    }
}

constexpr int NITEM = (TG / 64) * NH * 2;
constexpr int TQ_ITEM = 3072;
__host__ __device__ constexpr int tri_off(int i) { return i == 0 ? 0 : 4 * (2 * ((i - 1) >> 2) * (((i - 1) >> 2) + 1) + ((i - 1) & 3) * (((i - 1) >> 2) + 1)); }
constexpr int SA_WAVE_LDS = 9216 + 4096 + 1024;
static_assert(8 * SA_WAVE_LDS <= MISC_OFF, "stage A LDS map");
DI f32x4 mm4(f32x4 acc, const f32x4 aop, const f32x4 x) {
#pragma unroll
    for (int e = 0; e < 4; ++e) acc = __builtin_amdgcn_mfma_f32_16x16x4f32(aop[e], x[e], acc, 0, 0, 0);
    return acc; }
DI void ph_dn_stageA(CArgs& a, LAS unsigned char* lds, int g) {
    const int lane = otid() & 63, wave = __builtin_amdgcn_readfirstlane(otid() >> 6), gw = obid() * NWAVES + wave, NGW = gridDim.x * NWAVES;
    LAS unsigned char* wl = lds + wave * SA_WAVE_LDS;
    LAS float* Ap = (LAS float*)wl; LAS unsigned short* stg = (LAS unsigned short*)wl; LAS float* Sb = (LAS float*)(wl + 9216);
    LAS float* sgcF = (LAS float*)(wl + 9216 + 4096); LAS float* sbtF = sgcF + 64; LAS float* sgcB = sgcF + 128; LAS float* sbtB = sgcF + 192;
    const bf16* QN = (const bf16*)(a.ws + WS_QKVN); const float* BG = (const float*)(a.ws + WS_BG);
    bf16* TQ = (bf16*)(a.ws + ws_h(g)); float* SC = (float*)(a.ws + WS_SC);
    for (int pair = gw; pair < NITEM / 2; pair += NGW) {
        const int h = pair & 7, row0 = (pair >> 3) * 64, itemF = pair * 2, itemB = pair * 2 + 1;
        int lo_ = lane; asm volatile("" : "+v"(lo_));
        const int n = lo_ & 15, g4 = lo_ >> 4;
        { const int rf = row0 + lane, rb = row0 + 63 - lane;
          const float gvF = BG[(size_t)rf * 32 + 16 + h], btF = BG[(size_t)rf * 32 + h], gvB = BG[(size_t)rb * 32 + 24 + h], btB = BG[(size_t)rb * 32 + 8 + h];
          float gcF = gvF, gcB = gvB;
#pragma unroll
          for (int off = 1; off < 64; off <<= 1) {
              const float tF = __builtin_bit_cast(float, __builtin_amdgcn_ds_bpermute(((lane - off) & 63) << 2, __builtin_bit_cast(int, gcF)));
              const float tB = __builtin_bit_cast(float, __builtin_amdgcn_ds_bpermute(((lane - off) & 63) << 2, __builtin_bit_cast(int, gcB)));
              if (lane >= off) { gcF += tF; gcB += tB; } }
          const float glF = __builtin_bit_cast(float, __builtin_amdgcn_readlane(__builtin_bit_cast(int, gcF), 63)), glB = __builtin_bit_cast(float, __builtin_amdgcn_readlane(__builtin_bit_cast(int, gcB), 63));
          sgcF[lane] = gcF; sbtF[lane] = btF; sgcB[lane] = gcB; sbtB[lane] = btB;
          float* scF = SC + (size_t)itemF * 192; scF[lane] = __expf(gcF); scF[64 + lane] = btF; scF[128 + lane] = __expf(glF - gcF);
          float* scB = SC + (size_t)itemB * 192; scB[lane] = __expf(gcB); scB[64 + lane] = btB; scB[128 + lane] = __expf(glB - gcB); }
        bf16x8 kf[4][4];
#pragma unroll
        for (int blk = 0; blk < 4; ++blk) { const int row = row0 + 16 * blk + n;
#pragma unroll
            for (int s = 0; s < 4; ++s) kf[blk][s] = *(const bf16x8*)(QN + (size_t)row * 3072 + 1024 + h * HD + 32 * s + 8 * g4); }
#pragma unroll
        for (int dirb = 0; dirb < 2; ++dirb) {
#pragma unroll
            for (int mb = 0; mb < 4; ++mb) {
                const int rb0 = 16 * mb + 4 * g4;
                const f32x4 gFr = *(const LAS f32x4*)(sgcF + rb0), bFr = *(const LAS f32x4*)(sbtF + rb0), gBr = *(const LAS f32x4*)(sgcB + 60 - rb0);
#pragma unroll
                for (int nb = 0; nb <= mb; ++nb) {
                    f32x4 c = (f32x4){0.f, 0.f, 0.f, 0.f};
#pragma unroll
                    for (int s = 0; s < 4; ++s) c = MFMA16(kf[mb][s], kf[nb][s], c);
                    const int cc = 16 * nb + n, ib = 63 - cc; const float gFc = sgcF[cc], gBc = sgcB[ib], bBc = sbtB[ib];
                    const int tob = tri_off(ib);
#pragma unroll
                    for (int i = 0; i < 4; ++i) { const int r = rb0 + i;
                        if (r > cc) { if (dirb == 0) Ap[tri_off(r) + cc] = c[i] * __expf(fminf(gFr[i] - gFc, 0.f)) * bFr[i];
                                      else Ap[tob + (63 - r)] = c[i] * __expf(fminf(gBc - gBr[3 - i], 0.f)) * bBc; } }
                }
            }
            int toA[4];
#pragma unroll
            for (int bi = 0; bi < 4; ++bi) toA[bi] = tri_off(16 * bi + n) + 4 * g4;
#define SA_LDA(bi, bk) (*(const LAS f32x4*)(Ap + toA[bi] + 16 * (bk)))
#define SA_STS(j, X) do { _Pragma("unroll") for (int e = 0; e < 4; ++e) Sb[256 * (j) + (4 * g4 + e) * 16 + n] = (X)[e]; } while (0)
#define SA_LDS(j) (*(const LAS f32x4*)(Sb + 256 * (j) + n * 16 + 4 * g4))
            f32x4 T[4][4];
            f32x4 Nop[4], Nr[4], X[4], P[4];
#pragma unroll
            for (int j = 0; j < 4; ++j) {
                const f32x4 raw = SA_LDA(j, j);
#pragma unroll
                for (int e = 0; e < 4; ++e) { Nop[j][e] = (4 * g4 + e < n) ? raw[e] : 0.f;
                    Nr[j][e] = (n < 4 * g4 + e) ? Ap[tri_off(16 * j + 4 * g4 + e) + 16 * j + n] : 0.f;
                    X[j][e] = ((n == 4 * g4 + e) ? 1.f : 0.f) - Nr[j][e]; }
                P[j] = mm4((f32x4){0.f, 0.f, 0.f, 0.f}, Nop[j], Nr[j]);
                SA_STS(j, P[j]);
            }
#pragma unroll
            for (int st = 0; st < 3; ++st)
#pragma unroll
                for (int j = 0; j < 4; ++j) {
                    const f32x4 pop = SA_LDS(j);
                    X[j] = mm4(X[j], pop, X[j]);
                    if (st < 2) { P[j] = mm4((f32x4){0.f, 0.f, 0.f, 0.f}, pop, P[j]); SA_STS(j, P[j]); }
                    else SA_STS(j, X[j]);
                }
#pragma unroll
            for (int j = 0; j < 4; ++j) T[j][j] = X[j];
#pragma unroll
            for (int d = 1; d < 4; ++d)
#pragma unroll
                for (int j = 0; j + d < 4; ++j) { const int bi = j + d;
                    f32x4 W = (f32x4){0.f, 0.f, 0.f, 0.f};
#pragma unroll
                    for (int k = j; k < bi; ++k) W = mm4(W, SA_LDA(bi, k), T[k][j]);
                    const f32x4 R = mm4((f32x4){0.f, 0.f, 0.f, 0.f}, SA_LDS(bi), W);
                    T[bi][j] = -R; }
#undef SA_LDA
#undef SA_STS
#undef SA_LDS
            asm volatile("" ::: "memory");
#pragma unroll
            for (int bi = 0; bi < 4; ++bi)
#pragma unroll
                for (int bj = 0; bj < 4; ++bj)
#pragma unroll
                    for (int e = 0; e < 4; ++e) stg[(16 * bi + 4 * g4 + e) * 72 + 16 * bj + n] = (bj <= bi) ? (unsigned short)f2bf(T[bi][bj][e]) : (unsigned short)0;
            const int item = dirb ? itemB : itemF;
#pragma unroll
            for (int it = 0; it < 6; ++it) { const int pc = it * 64 + lane, r = pc < 128 ? (pc >> 2) : 32 + ((pc - 128) >> 3), ch = pc < 128 ? (pc & 3) : ((pc - 128) & 7);
                const v4u v = *(const LAS v4u*)(wl + r * 144 + ch * 16); *(v4u*)(TQ + (size_t)item * TQ_ITEM + pc * 8) = v; }
            asm volatile("" ::: "memory");
        }
        {
            f32x4 pq[4][4];
#pragma unroll
            for (int half = 0; half < 2; ++half) {
                bf16x8 qf2[2][4];
#pragma unroll
                for (int b2 = 0; b2 < 2; ++b2) { const int row = row0 + 16 * (2 * half + b2) + n;
#pragma unroll
                    for (int s = 0; s < 4; ++s) qf2[b2][s] = *(const bf16x8*)(QN + (size_t)row * 3072 + h * HD + 32 * s + 8 * g4); }
#pragma unroll
                for (int b2 = 0; b2 < 2; ++b2)
#pragma unroll
                    for (int nb = 0; nb < 4; ++nb) { f32x4 c = (f32x4){0.f, 0.f, 0.f, 0.f};
#pragma unroll
                        for (int s = 0; s < 4; ++s) c = MFMA16(qf2[b2][s], kf[nb][s], c);
                        pq[2 * half + b2][nb] = c; }
                asm volatile("" ::: "memory");
            }
#pragma unroll
            for (int dirb = 0; dirb < 2; ++dirb) {
#pragma unroll
                for (int mb = 0; mb < 4; ++mb) {
                    const int rb0 = 16 * mb + 4 * g4;
                    const f32x4 gFr = *(const LAS f32x4*)(sgcF + rb0), gBr = *(const LAS f32x4*)(sgcB + 60 - rb0);
#pragma unroll
                    for (int nb = 0; nb < 4; ++nb) {
                        const int cc = 16 * nb + n; const float gFc = sgcF[cc], gBc = sgcB[63 - cc];
#pragma unroll
                        for (int i = 0; i < 4; ++i) { const int r = rb0 + i;
                            if (dirb == 0) stg[r * 72 + cc] = (unsigned short)f2bf((nb <= mb && r >= cc) ? pq[mb][nb][i] * __expf(fminf(gFr[i] - gFc, 0.f)) : 0.f);
                            else stg[(63 - r) * 72 + (63 - cc)] = (unsigned short)f2bf((nb >= mb && r <= cc) ? pq[mb][nb][i] * __expf(fminf(gBr[3 - i] - gBc, 0.f)) : 0.f); }
                    }
                }
                const int item = dirb ? itemB : itemF;
#pragma unroll
                for (int it = 0; it < 6; ++it) { const int pc = it * 64 + lane, r = pc < 128 ? (pc >> 2) : 32 + ((pc - 128) >> 3), ch = pc < 128 ? (pc & 3) : ((pc - 128) & 7);
                    const v4u v = *(const LAS v4u*)(wl + r * 144 + ch * 16); *(v4u*)(TQ + (size_t)(NITEM + item) * TQ_ITEM + pc * 8) = v; }
                asm volatile("" ::: "memory");
            }
        }
    }
}
DI bf16x8 ld2x8(const LAS unsigned char* p0, const LAS unsigned char* p1) { const v2u lo = *(const LAS v2u*)p0, hi = *(const LAS v2u*)p1; return __builtin_bit_cast(bf16x8, (v4u){lo.x, lo.y, hi.x, hi.y}); }
DI bf16x8 pack16(const f32x16& x, int s) { v4u p; p.x = cvtpk(x[8 * s], x[8 * s + 1]); p.y = cvtpk(x[8 * s + 2], x[8 * s + 3]); p.z = cvtpk(x[8 * s + 4], x[8 * s + 5]); p.w = cvtpk(x[8 * s + 6], x[8 * s + 7]); return __builtin_bit_cast(bf16x8, p); }
DI void st2x8(LAS unsigned char* p, const v4u v) { *(LAS v2u*)p = (v2u){v.x, v.y}; *(LAS v2u*)(p + 8) = (v2u){v.z, v.w}; }
DI void stperm(LAS unsigned char* rowp, int c, const v4u v) { LAS unsigned char* p = rowp + (16 * (c >> 1) + 4 * (c & 1)) * 2; *(LAS v2u*)p = (v2u){v.x, v.y}; *(LAS v2u*)(p + 16) = (v2u){v.z, v.w}; }
#define SBAR() do { asm volatile("s_waitcnt lgkmcnt(0)" ::: "memory"); __builtin_amdgcn_s_barrier(); asm volatile("" ::: "memory"); } while (0)
#define MULS(x, y) ((x) * (y))
template <int VAR> DI void ph_dn_scan2(CArgs& a, LAS unsigned char* lds, int g) {
    const int t = otid(), lane = t & 63, wave = __builtin_amdgcn_readfirstlane(t >> 6), r = lane & 31, h5 = lane >> 5, i16 = lane & 15, q4 = i16 >> 2, p4 = i16 & 3, blk = (lane >> 4) & 1;
    constexpr int KP = 272, TP = 144, OP = 80;
    constexpr int O_K = 0, O_Q = 64 * KP, O_V = 2 * 64 * KP, O_T = 3 * 64 * KP, O_QK = O_T + 64 * TP, O_SC = O_QK + 64 * TP, SETB = O_SC + 768;
    static_assert(2 * SETB + 4 * 64 * OP <= MISC_OFF, "scan LDS map");
    for (int chain = obid(); chain < 192; chain += gridDim.x) {
        const int seq = chain < 64 ? 8 + (chain >> 4) : (chain - 64) >> 4, h = (chain >> 1) & 7, dir = chain & 1;
        const int s0 = seq < 8 ? seq * 4096 : 32768 + (seq - 8) * 8192, L = seq < 8 ? 4096 : 8192, NC = L >> 6;
        if (wave >= 4) {
            const int tl = t & 255;
            const bf16* QN = (const bf16*)(a.ws + WS_QKVN); const bf16* TQ = (const bf16*)(a.ws + ws_h(g)); const float* SC = (const float*)(a.ws + WS_SC);
            v4u rk[4], rq[4], rv[4], rt[2], rqk[2]; float rs = 0.f;
            int poff[4];
#pragma unroll
            for (int u = 0; u < 4; ++u) { const int idx = tl + 256 * u, ip = idx >> 4, ch = idx & 15; poff[u] = (dir ? 63 - ip : ip) * 3072 + ch * 8; }
#define DN_ISSUE(nn) do { const int r0_ = s0 + 64 * (dir ? NC - 1 - (nn) : (nn)); const size_t it_ = (size_t)(((r0_ >> 6) * 8 + h) * 2 + dir); \
            const bf16* qb_ = QN + (size_t)r0_ * 3072 + h * HD; const bf16* tb_ = TQ + it_ * TQ_ITEM; \
            _Pragma("unroll") for (int u = 0; u < 4; ++u) { rq[u] = *(const v4u*)(qb_ + poff[u]); rk[u] = *(const v4u*)(qb_ + 1024 + poff[u]); rv[u] = *(const v4u*)(qb_ + 2048 + poff[u]); } \
            _Pragma("unroll") for (int u = 0; u < 2; ++u) { const int pc = (u == 0 || tl < 128) ? tl + 256 * u : tl;     \
                rt[u] = *(const v4u*)(tb_ + pc * 8); rqk[u] = *(const v4u*)(tb_ + (size_t)NITEM * TQ_ITEM + pc * 8); } \
            if (tl < 192) rs = SC[it_ * 192 + tl]; } while (0)
#define DN_WRITE(set) do { LAS unsigned char* sb_ = lds + (set) * SETB; \
            _Pragma("unroll") for (int u = 0; u < 4; ++u) { const int idx = tl + 256 * u, ip = idx >> 4, ch = idx & 15; \
                stperm(sb_ + O_K + ip * KP, ch, rk[u]); stperm(sb_ + O_Q + ip * KP, ch, rq[u]); *(LAS v4u*)(sb_ + O_V + ip * KP + ch * 16) = rv[u]; } \
            _Pragma("unroll") for (int u = 0; u < 2; ++u) { if (u == 0 || tl < 128) { const int pc = tl + 256 * u, r_ = pc < 128 ? (pc >> 2) : 32 + ((pc - 128) >> 3), ch_ = pc < 128 ? (pc & 3) : ((pc - 128) & 7); \
                stperm(sb_ + O_T + r_ * TP, ch_, rt[u]); stperm(sb_ + O_QK + r_ * TP, ch_, rqk[u]); } } \
            if (tl < 192) ((LAS float*)(sb_ + O_SC))[tl] = rs; } while (0)
            if (VAR != 4) { DN_ISSUE(0); DN_WRITE(0); if (NC > 1) DN_ISSUE(1); }
            SBAR();
            for (int nn = 0; nn < NC; ++nn) {
                if (VAR != 4 && nn + 1 < NC) { DN_WRITE((nn + 1) & 1); if (nn + 2 < NC) DN_ISSUE(nn + 2); }
                SBAR();
            }
#undef DN_ISSUE
#undef DN_WRITE
        } else {
            bf16* O = (bf16*)(a.ws + (VAR ? (dir ? WS_QKVD + 64 * MiB : WS_QKVD) : (dir ? WS_OB : WS_OF)));
            LAS unsigned char* Ow = lds + 2 * SETB + wave * (64 * OP);
            f32x16 S[4];
#pragma unroll
            for (int kb = 0; kb < 4; ++kb)
#pragma unroll
                for (int i = 0; i < 16; ++i) S[kb][i] = 0.f;
            SBAR();
            for (int nn = 0; nn < NC; ++nn) {
                const LAS unsigned char* sb = lds + (nn & 1) * SETB;
                const LAS unsigned char* Kc = sb + O_K; const LAS unsigned char* Qc = sb + O_Q; const LAS unsigned char* Vt = sb + O_V;
                const LAS unsigned char* Tc = sb + O_T; const LAS unsigned char* QKc = sb + O_QK; const LAS float* sc = (const LAS float*)(sb + O_SC);
                if (VAR != 2) {
                const float eglast = sc[63];
#define LDA(base, pitch, row, col16) (*(const LAS bf16x8*)((base) + (row) * (pitch) + ((col16) * 16 + 8 * h5) * 2))
                f32x16 P[2], Qs[2];
#pragma unroll
                for (int mb = 0; mb < 2; ++mb)
#pragma unroll
                    for (int i = 0; i < 16; ++i) { P[mb][i] = 0.f; Qs[mb][i] = 0.f; }
                bf16x8 fa[2][4];
#define LDG(dst, j_) do { dst[0] = LDA(Kc, KP, r, (j_)); dst[1] = LDA(Kc, KP, 32 + r, (j_)); dst[2] = LDA(Qc, KP, r, (j_)); dst[3] = LDA(Qc, KP, 32 + r, (j_)); } while (0)
                LDG(fa[0], 0);
                bf16x8 tf[6];
#pragma unroll
                for (int j = 0; j < 8; ++j) {
                    if (j + 1 < 8) LDG(fa[(j + 1) & 1], j + 1);
                    else { tf[0] = LDA(Tc, TP, r, 0); tf[1] = LDA(Tc, TP, r, 1); tf[2] = LDA(Tc, TP, 32 + r, 0); tf[3] = LDA(Tc, TP, 32 + r, 1); tf[4] = LDA(Tc, TP, 32 + r, 2); tf[5] = LDA(Tc, TP, 32 + r, 3); }
                    __builtin_amdgcn_sched_barrier(0);
                    const bf16x8 Bf = pack16(S[j >> 1], j & 1);
                    if (VAR != 3) { P[0] = MFMA32(fa[j & 1][0], Bf, P[0]); P[1] = MFMA32(fa[j & 1][1], Bf, P[1]); Qs[0] = MFMA32(Bf, fa[j & 1][2], Qs[0]); Qs[1] = MFMA32(Bf, fa[j & 1][3], Qs[1]); }
                    __builtin_amdgcn_sched_barrier(0);
                }
#undef LDG
#pragma unroll
                for (int mb = 0; mb < 2; ++mb)
#pragma unroll
                    for (int gi = 0; gi < 4; ++gi) {
                        const int tb = 32 * mb + 8 * gi + 4 * h5;
                        const s16x4 v4 = __builtin_amdgcn_ds_read_tr16_b64_v4i16((LAS s16x4*)(Vt + (tb + q4) * KP + (32 * wave + 16 * blk + 4 * p4) * 2));
                        const f32x4 egc4 = *(const LAS f32x4*)(sc + tb), bt4 = *(const LAS f32x4*)(sc + 64 + tb);
#pragma unroll
                        for (int ii = 0; ii < 4; ++ii) P[mb][4 * gi + ii] = MULS(bt4[ii], bf2f((unsigned)(unsigned short)v4[ii]) - MULS(egc4[ii], P[mb][4 * gi + ii]));
                    }
                bf16x8 qf6[6];
                qf6[0] = LDA(QKc, TP, r, 0); qf6[1] = LDA(QKc, TP, r, 1); qf6[2] = LDA(QKc, TP, 32 + r, 0); qf6[3] = LDA(QKc, TP, 32 + r, 1); qf6[4] = LDA(QKc, TP, 32 + r, 2); qf6[5] = LDA(QKc, TP, 32 + r, 3);
                __builtin_amdgcn_sched_barrier(0);
                f32x16 Vn[2];
#pragma unroll
                for (int mb = 0; mb < 2; ++mb)
#pragma unroll
                    for (int i = 0; i < 16; ++i) Vn[mb][i] = 0.f;
                { const bf16x8 R00 = pack16(P[0], 0), R01 = pack16(P[0], 1), R10 = pack16(P[1], 0), R11 = pack16(P[1], 1);
                  Vn[0] = MFMA32(tf[0], R00, Vn[0]); Vn[1] = MFMA32(tf[2], R00, Vn[1]); Vn[0] = MFMA32(tf[1], R01, Vn[0]); Vn[1] = MFMA32(tf[3], R01, Vn[1]); Vn[1] = MFMA32(tf[4], R10, Vn[1]); Vn[1] = MFMA32(tf[5], R11, Vn[1]); }
                s16x4 kt[2][8];
#define LDKT(dst, kb) do { _Pragma("unroll") for (int mj = 0; mj < 2; ++mj) _Pragma("unroll") for (int s = 0; s < 2; ++s) { \
                    dst[(mj * 2 + s) * 2] = __builtin_amdgcn_ds_read_tr16_b64_v4i16((LAS s16x4*)(Kc + (32 * mj + 16 * s + 4 * h5 + q4) * KP + (32 * (kb) + 16 * blk + pc4) * 2)); \
                    dst[(mj * 2 + s) * 2 + 1] = __builtin_amdgcn_ds_read_tr16_b64_v4i16((LAS s16x4*)(Kc + (32 * mj + 16 * s + 8 + 4 * h5 + q4) * KP + (32 * (kb) + 16 * blk + pc4) * 2)); } } while (0)
                const int pc4 = (p4 == 1 ? 8 : (p4 == 2 ? 4 : 4 * p4));
                if (VAR != 5) {
                { const bf16x8 V00 = pack16(Vn[0], 0), V01 = pack16(Vn[0], 1), V10 = pack16(Vn[1], 0), V11 = pack16(Vn[1], 1);
#pragma unroll
                  for (int mb = 0; mb < 2; ++mb) {
                    const float eg = sc[32 * mb + r];
                    f32x16 o = Qs[mb] * eg;
                    if (mb == 0) { o = MFMA32(V00, qf6[0], o); o = MFMA32(V01, qf6[1], o); }
                    else { o = MFMA32(V00, qf6[2], o); o = MFMA32(V01, qf6[3], o); o = MFMA32(V10, qf6[4], o); o = MFMA32(V11, qf6[5], o); }
#pragma unroll
                    for (int gi = 0; gi < 4; ++gi) { if (VAR != 8) *(LAS v2u*)(Ow + (32 * mb + r) * OP + (8 * gi + 4 * h5) * 2) = (v2u){cvtpk(o[4 * gi], o[4 * gi + 1]), cvtpk(o[4 * gi + 2], o[4 * gi + 3])}; else asm volatile("" :: "v"(o[4 * gi])); }
                  } }
                }
#pragma unroll
                for (int mb = 0; mb < 2; ++mb)
#pragma unroll
                    for (int gi = 0; gi < 4; ++gi) { const f32x4 ekd4 = *(const LAS f32x4*)(sc + 128 + 32 * mb + 8 * gi + 4 * h5);
#pragma unroll
                        for (int ii = 0; ii < 4; ++ii) Vn[mb][4 * gi + ii] = MULS(Vn[mb][4 * gi + ii], ekd4[ii]); }
                if (VAR != 6) LDKT(kt[0], 0);
                { const bf16x8 W[4] = {pack16(Vn[0], 0), pack16(Vn[0], 1), pack16(Vn[1], 0), pack16(Vn[1], 1)};
#pragma unroll
                  for (int kb = 0; kb < 4; ++kb) {
                    if (VAR != 6 && kb + 1 < 4) LDKT(kt[(kb + 1) & 1], kb + 1);
                    __builtin_amdgcn_sched_barrier(0);
#pragma unroll
                    for (int i = 0; i < 16; ++i) S[kb][i] = MULS(S[kb][i], eglast);
#pragma unroll
                    for (int q = 0; q < 4; ++q) if (VAR != 6) S[kb] = MFMA32(__builtin_shufflevector(kt[kb & 1][2 * q], kt[kb & 1][2 * q + 1], 0, 1, 2, 3, 4, 5, 6, 7), W[q], S[kb]);
                    __builtin_amdgcn_sched_barrier(0);
                  } }
#undef LDA
#undef LDKT
                if (VAR != 5 && VAR != 8) {
                { const int row0 = s0 + 64 * (dir ? NC - 1 - nn : nn);
#pragma unroll
                  for (int it = 0; it < 4; ++it) { const int idx = it * 64 + lane, ip = idx >> 2, ch = idx & 3;
                      const v4u ov_ = *(const LAS v4u*)(Ow + ip * OP + ch * 16); if (VAR != 7) *(v4u*)(O + (size_t)(row0 + (dir ? 63 - ip : ip)) * 1024 + h * HD + 32 * wave + ch * 8) = ov_; else asm volatile("" :: "v"(ov_)); } }
                }
                }
                SBAR();
            }
        }
    }
}
DI void ph_dn_merge(CArgs& a, int l) {
    const int lane = otid() & 63, wave = __builtin_amdgcn_readfirstlane(otid() >> 6), gw = obid() * NWAVES + wave, NGW = gridDim.x * NWAVES;
    const bf16* OF = (const bf16*)(a.ws + WS_OF); const bf16* OB = (const bf16*)(a.ws + WS_OB); const bf16* Z = (const bf16*)(a.ws + WS_Z); bf16* MIX = (bf16*)(a.ws + WS_MIX);
    const float* gain = a.in[9] + (size_t)l * HD + (lane & 7) * 16;
    float gn[16];
#pragma unroll
    for (int i = 0; i < 16; ++i) gn[i] = gain[i];
    for (int r = gw; r < TG; r += NGW) {
        float o[16], z[16]; float ss = 0.f;
#pragma unroll
        for (int hf = 0; hf < 2; ++hf) {
            const v4u f = *(const v4u*)(OF + (size_t)r * 1024 + lane * 16 + hf * 8), b = *(const v4u*)(OB + (size_t)r * 1024 + lane * 16 + hf * 8), zz = *(const v4u*)(Z + (size_t)r * 1024 + lane * 16 + hf * 8);
            const unsigned fw[4] = {f.x, f.y, f.z, f.w}, bw[4] = {b.x, b.y, b.z, b.w}, zw[4] = {zz.x, zz.y, zz.z, zz.w};
#pragma unroll
            for (int k = 0; k < 4; ++k) { o[hf * 8 + 2 * k] = bflo(fw[k]) + bflo(bw[k]); o[hf * 8 + 2 * k + 1] = bfhi(fw[k]) + bfhi(bw[k]); z[hf * 8 + 2 * k] = bflo(zw[k]); z[hf * 8 + 2 * k + 1] = bfhi(zw[k]); }
        }
#pragma unroll
        for (int i = 0; i < 16; ++i) ss += o[i] * o[i];
        ss += shx(ss, 1); ss += shx(ss, 2); ss += shx(ss, 4);
        const float rinv = rsqrtf(ss * (1.f / HD) + EPS);
        unsigned w[8];
#pragma unroll
        for (int k = 0; k < 8; ++k) w[k] = pk2(o[2 * k] * rinv * gn[2 * k] * siluf(z[2 * k]), o[2 * k + 1] * rinv * gn[2 * k + 1] * siluf(z[2 * k + 1]));
        *(v4u*)(MIX + (size_t)r * DM + 1024 + lane * 16) = (v4u){w[0], w[1], w[2], w[3]};
        *(v4u*)(MIX + (size_t)r * DM + 1024 + lane * 16 + 8) = (v4u){w[4], w[5], w[6], w[7]};
    }
}
DI void ph_ffn_fix(CArgs& a, int l) {
    const bf16* ED = (const bf16*)(a.ws + WS_EDGE); bf16* GA = (bf16*)(a.ws + WS_GACT);
    const float* cw = a.in[14] + (size_t)l * 3 * NUP; const float* cb = a.in[15] + (size_t)l * NUP;
    constexpr int NCG = DFF / 8, NBLK = TG / 64;
    for (int task = obid() * NTHR + otid(); task < NBLK * NCG * 2; task += gridDim.x * NTHR) {
        const int which = task & 1, t2 = task >> 1, blk = t2 / NCG, c0 = (t2 % NCG) * 8, row0 = blk * 64;
        int s0, L; seq_of(row0, s0, L);
        const v4u zz = (v4u){0u, 0u, 0u, 0u};
        const bf16* e = ED + (size_t)blk * 4 * NUP + c0;
        v4u pg, pu, cg, cu, ng, nu; int row;
        if (which == 0) { row = row0; const bool hp = row0 > s0;
            pg = hp ? *(const v4u*)(e - NUP) : zz; pu = hp ? *(const v4u*)(e - NUP + DFF) : zz;
            cg = *(const v4u*)e; cu = *(const v4u*)(e + DFF); ng = *(const v4u*)(e + NUP); nu = *(const v4u*)(e + NUP + DFF); }
        else { row = row0 + 63; const bool hn = row0 + 64 < s0 + L;
            pg = *(const v4u*)(e + 2 * NUP); pu = *(const v4u*)(e + 2 * NUP + DFF); cg = *(const v4u*)(e + 3 * NUP); cu = *(const v4u*)(e + 3 * NUP + DFF);
            ng = hn ? *(const v4u*)(e + 4 * NUP) : zz; nu = hn ? *(const v4u*)(e + 4 * NUP + DFF) : zz; }
        const unsigned a0[4] = {pg.x, pg.y, pg.z, pg.w}, a1[4] = {cg.x, cg.y, cg.z, cg.w}, a2[4] = {ng.x, ng.y, ng.z, ng.w};
        const unsigned b0[4] = {pu.x, pu.y, pu.z, pu.w}, b1[4] = {cu.x, cu.y, cu.z, cu.w}, b2[4] = {nu.x, nu.y, nu.z, nu.w};
        unsigned w[4];
#pragma unroll
        for (int k = 0; k < 4; ++k) {
            const int c = c0 + 2 * k;
            const float g0 = cw[c] * bflo(a0[k]) + cw[NUP + c] * bflo(a1[k]) + cw[2 * NUP + c] * bflo(a2[k]) + cb[c];
            const float g1 = cw[c + 1] * bfhi(a0[k]) + cw[NUP + c + 1] * bfhi(a1[k]) + cw[2 * NUP + c + 1] * bfhi(a2[k]) + cb[c + 1];
            const float u0 = cw[DFF + c] * bflo(b0[k]) + cw[NUP + DFF + c] * bflo(b1[k]) + cw[2 * NUP + DFF + c] * bflo(b2[k]) + cb[DFF + c];
            const float u1 = cw[DFF + c + 1] * bfhi(b0[k]) + cw[NUP + DFF + c + 1] * bfhi(b1[k]) + cw[2 * NUP + DFF + c + 1] * bfhi(b2[k]) + cb[DFF + c + 1];
            w[k] = cvtpk(siluf(g0) * u0, siluf(g1) * u1);
        }
        *(v4u*)(GA + (size_t)row * DFF + c0) = (v4u){w[0], w[1], w[2], w[3]};
    }
}
#ifndef SCANVAR
#define SCANVAR 0
#endif
#ifndef WGM_IN
#define WGM_IN 4
#endif
#ifndef WGM_OUT
#define WGM_OUT 4
#endif
#ifndef WGM_UP
#define WGM_UP 4
#endif
#ifndef WGM_DN
#define WGM_DN 4
#endif
#ifndef PROBE
#define PROBE 0
#endif
#ifndef ATTVAR
#define ATTVAR 0
#endif
constexpr int NSTEPS = 1 + DEPTH * (1 + NGRP * (7 + 3 + 1)) + NGRP + ((PROBE & 64) ? DEPTH * NGRP : 0);
__global__ void __launch_bounds__(NTHR, 2) fwd(Args a_unused) {
    extern __shared__ __attribute__((aligned(16))) unsigned char lds_raw[];
    LAS unsigned char* lds = (LAS unsigned char*)lds_raw;
    const int tid = threadIdx.x;
    CArgs* ap0 = (CArgs*)__builtin_amdgcn_kernarg_segment_ptr();
#define a (*({ CArgs* p_ = ap0; asm volatile("" : "+s"(p_)); p_; }))
    volatile LAS unsigned* MISC = (volatile LAS unsigned*)(lds + MISC_OFF);
    for (int u = tid; u < (LDS_BYTES - MISC_OFF) / 4; u += NTHR) ((LAS unsigned*)(lds + MISC_OFF))[u] = 0u;
    __syncthreads();
    unsigned* ctl = (unsigned*)(a.ws + WS_CTL);
    const bool single = (a.s_hi - a.s_lo) > 1;
    XcdBarrier bar; bar.bar = ctl + CW_BAR; bar.x = 0; bar.st = nullptr;
    if (single) bar = xcd_barrier_post(ctl + CW_BAR, MISC + 8);
    int step = 0, L0 = 0, G0 = 0, HF0 = 0;
#define REP(bit) for (int rep_ = 0; rep_ < (((PROBE) >> (bit)) & 1) + 1; ++rep_)
#define RUN(...) do { if (step >= a.s_lo && step < a.s_hi) { int l = L0, g = G0, half = HF0; asm volatile("" : "+s"(l), "+s"(g), "+s"(half)); (void)l; (void)g; (void)half; __builtin_amdgcn_s_waitcnt(0);   __VA_ARGS__; if (step + 1 < a.s_hi) { XcdBarrier b2_ = bar; asm volatile("" : "+s"(b2_.bar), "+s"(b2_.x)); xcd_barrier(b2_); } } ++step; } while (0)
    RUN(ph_bias(a.in[2], (float*)(a.ws + WS_BIAS)));
    for (L0 = 0; L0 < DEPTH; ++L0) {
        RUN(REP(5) ph_weights(a, l, lds));
        for (G0 = 0; G0 < NGRP; ++G0) {
            if (L0 == 0) RUN(REP(4) ph_prenorm(a, l, g));
            RUN(REP(0) { pg8::Gemm gm{(const bf16*)(a.ws + ws_h(g)), (const bf16*)(a.ws + WS_WIN), TG, INP, DM}; pg8::StaticOrder S; S.init(TG, INP, (int)gridDim.x, (int)blockIdx.x, WGM_IN);
                  pg8::EpiRoute E{(bf16*)(a.ws + WS_QKVA), (bf16*)(a.ws + WS_QKVD), (bf16*)(a.ws + WS_Z), (float*)(a.ws + WS_GATES), 3072, 3072, 1024, 12, 24, 28};
                  pg8::gemm_phase<pg8::EpiRoute, pg8::StaticOrder, true, true>(lds, gm, S, E); });
            RUN(REP(1) ph_dn_prep(a, l));
            RUN(REP(2) ph_dn_stageA(a, lds, g));
            RUN(REP(3) { if (rep_ == 0) ph_dn_scan2<0>(a, lds, g); else if (SCANVAR >= 0) ph_dn_scan2<(SCANVAR >= 0 ? SCANVAR : 0)>(a, lds, g); ph_attn2<0>(a, lds, l, g, rep_); });
#if (PROBE & 64)
            RUN(ph_attn2<ATTVAR>(a, lds, l, g, 1));
#endif
            RUN(REP(4) { ph_attn_merge(a, l); ph_dn_merge(a, l); });
            RUN(REP(0) { pg8::Gemm gm{(const bf16*)(a.ws + WS_MIX), (const bf16*)(a.ws + WS_WOUT), TG, DM, DM}; pg8::StaticOrder S; S.init(TG, DM, (int)gridDim.x, (int)blockIdx.x, WGM_OUT);
                  pg8::EpiRoute E{(bf16*)(a.ws + WS_MIXED), nullptr, nullptr, nullptr, DM, 0, 0, 1 << 20, 1 << 20, 1 << 20};
                  pg8::gemm_phase<pg8::EpiRoute, pg8::StaticOrder, true, true>(lds, gm, S, E); });
            RUN({ ph_postmix<0>(a, l, g); if (PROBE & 256) ph_postmix<1>(a, l, g); });
            RUN(REP(0) { pg8::Gemm gm{(const bf16*)(a.ws + ws_h(g)), (const bf16*)(a.ws + WS_WUP), TG, NUP, DM}; pg8::StaticOrder S; S.init(TG, NUP, (int)gridDim.x, (int)blockIdx.x, WGM_UP);
                  pg8::EpiGate E{(bf16*)(a.ws + WS_GACT), (bf16*)(a.ws + WS_EDGE), a.in[14] + (size_t)l * 3 * NUP, a.in[15] + (size_t)l * NUP};
                  pg8::gemm_phase<pg8::EpiGate, pg8::StaticOrder, true, true>(lds, gm, S, E); });
            RUN(REP(7) ph_ffn_fix(a, l));
            RUN(REP(0) { pg8::Gemm gm{(const bf16*)(a.ws + WS_GACT), (const bf16*)(a.ws + WS_WDN), TG, DM, DFF}; pg8::StaticOrder S; S.init(TG, DM, (int)gridDim.x, (int)blockIdx.x, WGM_DN);
                  pg8::EpiRoute E{(bf16*)(a.ws + WS_F), nullptr, nullptr, nullptr, DM, 0, 0, 1 << 20, 1 << 20, 1 << 20};
                  pg8::gemm_phase<pg8::EpiRoute, pg8::StaticOrder, true, true>(lds, gm, S, E); });
            RUN({ ph_postffn<0>(a, l, g); if (PROBE & 512) ph_postffn<1>(a, l, g); });
        }
    }
#undef RUN
#undef a
}

#ifndef ONE_LAUNCH
#define ONE_LAUNCH 1
#endif
extern "C" void kernel_launch(void* const* d_in, const int* in_sizes, int n_in, void* d_out, int out_size, void* d_ws, size_t ws_size, hipStream_t stream) {
    static int grid = 0;
    if (grid == 0) {
        if (n_in != 18 || ws_size < WS_END || out_size != 2 * 32768 * DM) { fprintf(stderr, "kernel_launch: unexpected shapes (n_in %d, out %d, ws %zu; need ws >= %zu)\n", n_in, out_size, ws_size, (size_t)WS_END); grid = -1; return; }
        int dev = 0, cus = 0;
        if (hipGetDevice(&dev) != hipSuccess || hipDeviceGetAttribute(&cus, hipDeviceAttributeMultiprocessorCount, dev) != hipSuccess) { grid = -1; return; }
        if (hipFuncSetAttribute((const void*)fwd, hipFuncAttributeMaxDynamicSharedMemorySize, LDS_BYTES) != hipSuccess) { fprintf(stderr, "kernel_launch: hipFuncSetAttribute failed\n"); grid = -1; return; }
        int per_cu = 0;
        if (hipOccupancyMaxActiveBlocksPerMultiprocessor(&per_cu, (const void*)fwd, NTHR, LDS_BYTES) != hipSuccess || per_cu < 1) { fprintf(stderr, "kernel_launch: occupancy query says %d\n", per_cu); }
        (void)hipGetLastError();
        grid = cus;
    }
    if (grid < 0) return;
    (void)hipMemsetAsync((char*)d_ws + WS_CTL, 0, CTL_ZERO_BYTES, stream);
    Args a{};
    for (int i = 0; i < 18; ++i) a.in[i] = (const float*)d_in[i];
    a.out = (float*)d_out; a.ws = (unsigned char*)d_ws;
    if (ONE_LAUNCH) { a.s_lo = 0; a.s_hi = NSTEPS; hipLaunchKernelGGL(fwd, dim3(grid), dim3(NTHR), LDS_BYTES, stream, a); }
    else for (int s = 0; s < NSTEPS; ++s) { a.s_lo = s; a.s_hi = s + 1; hipLaunchKernelGGL(fwd, dim3(grid), dim3(NTHR), LDS_BYTES, stream, a); }
}
```

```cpp
#include <hip/hip_runtime.h>
#include <cstdio>
#include <cstdint>
namespace pg8 {
#define PG8_LAS __attribute__((address_space(3)))
typedef unsigned short bf16_t;
typedef short bf16x8 __attribute__((ext_vector_type(8)));
typedef float f32x4 __attribute__((ext_vector_type(4)));
typedef unsigned u32x4 __attribute__((ext_vector_type(4)));
constexpr int BM = 256, BK = 64, HALF = 128, HTB = HALF * BK * 2  , STAGE_BYTES = 8 * HTB, NXCD = 8, WGM = 4;

__host__ __device__ __forceinline__ int lds_byte(int r, int c) { const int st = (r >> 4) * 2 + (c >> 5), rr = r & 15, cc = c & 31, ob = rr * 64 + cc * 2; return st * 1024 + (ob ^ (((ob >> 9) & 1) << 5)); }
__host__ __device__ __forceinline__ void stage_rc(int b, int& R, int& C) { const int st = b / 1024, sb = b % 1024, swz = sb ^ (((sb >> 9) & 1) << 5); R = (st >> 1) * 16 + swz / 64; C = (st & 1) * 32 + (swz % 64) / 2; }
__host__ __device__ __forceinline__ int perm32(int rho) { const int n = rho >> 4, i = rho & 15; return 8 * (i >> 2) + 4 * n + (i & 3); }

struct Unit { int pm, pn; };
struct Gemm { const bf16_t* A; const bf16_t* Bt; int M, N, K; };

struct StaticOrder {
    int nM, nN, nwg, G, c, wgm;
    __host__ __device__ void init(int M, int N, int G_, int c_, int wgm_ = WGM) { nM = M / BM; nN = N / BM; nwg = nM * nN; G = G_; c = c_; wgm = wgm_; }
    __host__ __device__ bool next(int i, Unit& u) const {
        const long L = (long)i * G + c; if (L >= nwg) return false;
        int wgid = (int)L; { const int q = nwg / NXCD, r = nwg % NXCD, xcd = wgid % NXCD, off = wgid / NXCD; wgid = (xcd < r ? xcd * (q + 1) : r * (q + 1) + (xcd - r) * q) + off; }
        const int nig = wgm * nN, gid = wgid / nig, fm = gid * wgm, gsz = (nM - fm) < wgm ? (nM - fm) : wgm;
        u.pm = fm + ((wgid % nig) % gsz); u.pn = (wgid % nig) / gsz; return true;
    }
    __device__ __forceinline__ void a_ready(const Unit&) const {}
    __device__ __forceinline__ void done(const Unit&) const {}
};
__device__ __forceinline__ unsigned cvt_pk_bf16(float lo, float hi) { unsigned r; asm volatile("v_cvt_pk_bf16_f32 %0, %1, %2" : "=v"(r) : "v"(lo), "v"(hi)); return r; }
struct EpiRoute {
    static constexpr bool PERM = true, AFTER_DRAIN = false;
    bf16_t* d0; bf16_t* d1; bf16_t* d2; float* gates;
    int ld0, ld1, ld2, t1, t2, t3;
    __device__ __forceinline__ void operator()(const f32x4 (&acc)[2][2][4][2], const Unit& u, int wr, int wc, int fr, int fq) const {
        const int row0 = u.pm * BM + wr * 64 + fr;
        if (u.pn >= t3) {
            if (wc == 0) {
#pragma unroll
                for (int ai = 0; ai < 2; ++ai)
#pragma unroll
                    for (int m = 0; m < 4; ++m) { float* rowp = gates + (size_t)(row0 + ai * HALF + m * 16) * 32 + 8 * fq;
                        *(f32x4*)(rowp) = acc[ai][0][m][0]; *(f32x4*)(rowp + 4) = acc[ai][0][m][1]; }
            }
            return;
        }
        bf16_t* base; int ldc, colt;
        if (u.pn < t1) { base = d0; ldc = ld0; colt = u.pn * BM; }
        else if (u.pn < t2) { base = d1; ldc = ld1; colt = (u.pn - t1) * BM; }
        else { base = d2; ldc = ld2; colt = (u.pn - t2) * BM; }
        const int col0 = colt + wc * 32 + 8 * fq;
#pragma unroll
        for (int ai = 0; ai < 2; ++ai)
#pragma unroll
            for (int m = 0; m < 4; ++m) { bf16_t* rowp = base + (size_t)(row0 + ai * HALF + m * 16) * ldc + col0;
#pragma unroll
                for (int bj = 0; bj < 2; ++bj) { const f32x4 v0 = acc[ai][bj][m][0], v1 = acc[ai][bj][m][1];
                    u32x4 w; w.x = cvt_pk_bf16(v0[0], v0[1]); w.y = cvt_pk_bf16(v0[2], v0[3]); w.z = cvt_pk_bf16(v1[0], v1[1]); w.w = cvt_pk_bf16(v1[2], v1[3]);
                    *(u32x4*)(rowp + bj * HALF) = w; } }
    }
};

constexpr int E_DFF = 5632, E_NUP = 11264;
__device__ __forceinline__ float dpp_ror1(float x) { return __builtin_bit_cast(float, __builtin_amdgcn_mov_dpp(__builtin_bit_cast(int, x), 0x121, 0xf, 0xf, true)); }
__device__ __forceinline__ float dpp_rol1(float x) { return __builtin_bit_cast(float, __builtin_amdgcn_mov_dpp(__builtin_bit_cast(int, x), 0x12F, 0xf, 0xf, true)); }
typedef unsigned u32x2 __attribute__((ext_vector_type(2)));
struct EpiGate {
    static constexpr bool PERM = true, AFTER_DRAIN = false;
    bf16_t* GA; bf16_t* EDGE; const float* cw; const float* cb;
    __device__ __forceinline__ void operator()(const f32x4 (&acc)[2][2][4][2], const Unit& u, int wr, int wc, int fr, int fq) const {
        const int rowb = u.pm * BM + wr * 64;
        f32x4 WT[2][8];
#pragma unroll
        for (int n = 0; n < 2; ++n) {
            const int ch0 = u.pn * 128 + wc * 32 + fq * 8 + n * 4;
            WT[n][0] = *(const f32x4*)(cw + ch0); WT[n][1] = *(const f32x4*)(cw + E_NUP + ch0); WT[n][2] = *(const f32x4*)(cw + 2 * E_NUP + ch0);
            WT[n][3] = *(const f32x4*)(cw + E_DFF + ch0); WT[n][4] = *(const f32x4*)(cw + E_NUP + E_DFF + ch0); WT[n][5] = *(const f32x4*)(cw + 2 * E_NUP + E_DFF + ch0);
            WT[n][6] = *(const f32x4*)(cb + ch0); WT[n][7] = *(const f32x4*)(cb + E_DFF + ch0);
        }
#pragma unroll
        for (int n = 0; n < 2; ++n) {
            const int ch0 = u.pn * 128 + wc * 32 + fq * 8 + n * 4;
            const f32x4 wg0 = WT[n][0], wg1 = WT[n][1], wg2 = WT[n][2], wu0 = WT[n][3], wu1 = WT[n][4], wu2 = WT[n][5], bg = WT[n][6], bu = WT[n][7];
#pragma unroll
            for (int ai = 0; ai < 2; ++ai) {
                const int blk = (rowb + ai * HALF) >> 6;
#pragma unroll
                for (int m = 0; m < 4; ++m) {
                    const f32x4 cg = acc[ai][0][m][n], cu = acc[ai][1][m][n];
                    float o[4];
#pragma unroll
                    for (int i = 0; i < 4; ++i) {
                        const float sgp = (m > 0 && fr == 15) ? acc[ai][0][m > 0 ? m - 1 : 0][n][i] : cg[i], sup = (m > 0 && fr == 15) ? acc[ai][1][m > 0 ? m - 1 : 0][n][i] : cu[i];
                        const float sgn = (m < 3 && fr == 0) ? acc[ai][0][m < 3 ? m + 1 : 3][n][i] : cg[i], sun = (m < 3 && fr == 0) ? acc[ai][1][m < 3 ? m + 1 : 3][n][i] : cu[i];
                        const float pg = dpp_ror1(sgp), pu = dpp_ror1(sup), ng = dpp_rol1(sgn), nu = dpp_rol1(sun);
                        const float g = wg0[i] * pg + wg1[i] * cg[i] + wg2[i] * ng + bg[i];
                        const float uu = wu0[i] * pu + wu1[i] * cu[i] + wu2[i] * nu + bu[i];
                        o[i] = g * __builtin_amdgcn_rcpf(1.f + __expf(-g)) * uu;
                    }
                    const bool edge = (m == 0 && fr == 0) || (m == 3 && fr == 15);
                    if (!edge) { u32x2 w; w.x = cvt_pk_bf16(o[0], o[1]); w.y = cvt_pk_bf16(o[2], o[3]); *(u32x2*)(GA + (size_t)(rowb + ai * HALF + m * 16 + fr) * E_DFF + ch0) = w; }
                    if (m == 0 && fr < 2) { bf16_t* ep = EDGE + ((size_t)blk * 4 + fr) * E_NUP + ch0;
                        u32x2 w; w.x = cvt_pk_bf16(cg[0], cg[1]); w.y = cvt_pk_bf16(cg[2], cg[3]); *(u32x2*)ep = w; w.x = cvt_pk_bf16(cu[0], cu[1]); w.y = cvt_pk_bf16(cu[2], cu[3]); *(u32x2*)(ep + E_DFF) = w; }
                    if (m == 3 && fr >= 14) { bf16_t* ep = EDGE + ((size_t)blk * 4 + 2 + (fr - 14)) * E_NUP + ch0;
                        u32x2 w; w.x = cvt_pk_bf16(cg[0], cg[1]); w.y = cvt_pk_bf16(cg[2], cg[3]); *(u32x2*)ep = w; w.x = cvt_pk_bf16(cu[0], cu[1]); w.y = cvt_pk_bf16(cu[2], cu[3]); *(u32x2*)(ep + E_DFF) = w; }
                }
            }
        }
    }
};

__device__ __forceinline__ float xch_sum4(float x) {
    float a = x, b = x;
    asm volatile("s_nop 1\n\tv_permlane16_swap_b32 %0, %1\n\ts_nop 1" : "+v"(a), "+v"(b));
    x = a + b; a = x; b = x;
    asm volatile("s_nop 1\n\tv_permlane32_swap_b32 %0, %1\n\ts_nop 1" : "+v"(a), "+v"(b));
    return a + b; }
struct EpiPM {
    static constexpr bool PERM = true, AFTER_DRAIN = false;
    const unsigned long long __attribute__((address_space(4)))* ka;
    int gi1, gi2, goff1, goff2;
    unsigned h_off, xch_off, cnt_off;
    PG8_LAS float* sc;
    int npan, last;
    unsigned dbg_mixed, dbg_x, dbg_h;
    __device__ __forceinline__ void exchange(int which, const float (&p)[2][4], float (&r)[2][4], const Unit& u, int t, int wr, int wc, int fr, int fq) const {
#pragma unroll
        for (int ai = 0; ai < 2; ++ai)
#pragma unroll
            for (int m = 0; m < 4; ++m) { const float v = xch_sum4(p[ai][m]); if (fq == 0) sc[wc * 256 + ai * HALF + wr * 64 + m * 16 + fr] = v; }
        asm volatile("s_waitcnt lgkmcnt(0)" ::: "memory"); __builtin_amdgcn_s_barrier(); asm volatile("" ::: "memory");
        unsigned char* ws_ = (unsigned char*)ka[19];
        typedef __attribute__((address_space(1))) unsigned gu32;
        gu32* sl = (gu32*)(unsigned*)(ws_ + xch_off) + ((size_t)which * npan + u.pm) * 2048;
        if (t < 256) { const float part = (sc[t] + sc[256 + t]) + (sc[512 + t] + sc[768 + t]);
            __hip_atomic_store(sl + u.pn * 256 + t, __builtin_bit_cast(unsigned, part), __ATOMIC_RELAXED, __HIP_MEMORY_SCOPE_AGENT); }
        asm volatile("s_waitcnt vmcnt(0) lgkmcnt(0)" ::: "memory"); __builtin_amdgcn_s_barrier(); asm volatile("" ::: "memory");
        if (t == 0) { gu32* c = (gu32*)(unsigned*)(ws_ + cnt_off) + which * npan + u.pm; __hip_atomic_fetch_add(c, 1u, __ATOMIC_RELAXED, __HIP_MEMORY_SCOPE_AGENT);
            while (__hip_atomic_load(c, __ATOMIC_RELAXED, __HIP_MEMORY_SCOPE_AGENT) < 8u) __builtin_amdgcn_s_sleep(1);
            __builtin_amdgcn_fence(__ATOMIC_ACQUIRE, "agent"); }
        asm volatile("s_waitcnt vmcnt(0) lgkmcnt(0)" ::: "memory"); __builtin_amdgcn_s_barrier(); asm volatile("" ::: "memory");
        if (t < 256) { float tot = 0.f;
#pragma unroll
            for (int q = 0; q < 8; ++q) tot += __builtin_bit_cast(float, __hip_atomic_load(sl + q * 256 + t, __ATOMIC_RELAXED, __HIP_MEMORY_SCOPE_AGENT));
            const float rs_ = __builtin_amdgcn_rsqf(tot * (1.f / 2048.f) + 1e-6f); sc[1024 + t] = rs_;
            if (dbg_mixed && u.pn == 0) ((float*)(ws_ + xch_off + (4u << 20)))[(size_t)which * 65536 + u.pm * 256 + t] = rs_; }
        asm volatile("s_waitcnt vmcnt(0) lgkmcnt(0)" ::: "memory"); __builtin_amdgcn_s_barrier(); asm volatile("" ::: "memory");
#pragma unroll
        for (int ai = 0; ai < 2; ++ai)
#pragma unroll
            for (int m = 0; m < 4; ++m) r[ai][m] = sc[1024 + ai * HALF + wr * 64 + m * 16 + fr];
        asm volatile("s_waitcnt lgkmcnt(0)" ::: "memory"); __builtin_amdgcn_s_barrier(); asm volatile("" ::: "memory");
    }
    __device__ __forceinline__ void operator()(const f32x4 (&acc_)[2][2][4][2], const Unit& u, int wr, int wc, int fr_, int fq_) const {
        f32x4 (&acc)[2][2][4][2] = const_cast<f32x4 (&)[2][2][4][2]>(acc_);
        (void)fr_; (void)fq_;
#define EPM_LANE() int lane_ = (int)__builtin_amdgcn_mbcnt_hi(~0u, __builtin_amdgcn_mbcnt_lo(~0u, 0u)); asm volatile("" : "+v"(lane_)); const int fr = lane_ & 15, fq = lane_ >> 4; \
        const int t = (wr * 4 + wc) * 64 + fq * 16 + fr; const int col0 = u.pn * BM + wc * 32 + 8 * fq; (void)t; (void)col0
        float* xrow = (float*)ka[18];
        float p[2][4], rinv[2][4];
        if (dbg_mixed) { EPM_LANE(); bf16_t* MX = (bf16_t*)((unsigned char*)ka[19] + dbg_mixed);
#pragma unroll
            for (int ai = 0; ai < 2; ++ai)
#pragma unroll
                for (int m = 0; m < 4; ++m) { const size_t R = (size_t)u.pm * BM + ai * HALF + wr * 64 + m * 16 + fr;
#pragma unroll
                    for (int bj = 0; bj < 2; ++bj) { const f32x4 v0 = acc[ai][bj][m][0], v1 = acc[ai][bj][m][1];
                        u32x4 w; w.x = cvt_pk_bf16(v0[0], v0[1]); w.y = cvt_pk_bf16(v0[2], v0[3]); w.z = cvt_pk_bf16(v1[0], v1[1]); w.w = cvt_pk_bf16(v1[2], v1[3]);
                        *(u32x4*)(MX + R * 2048 + col0 + bj * HALF) = w; } } }
        { EPM_LANE();
#pragma unroll
        for (int ai = 0; ai < 2; ++ai)
#pragma unroll
            for (int m = 0; m < 4; ++m) { float s = 0.f;
#pragma unroll
                for (int bj = 0; bj < 2; ++bj)
#pragma unroll
                    for (int n = 0; n < 2; ++n) { const f32x4 v = acc[ai][bj][m][n]; s += (v[0] * v[0] + v[1] * v[1]) + (v[2] * v[2] + v[3] * v[3]); }
                p[ai][m] = s; }
        exchange(0, p, rinv, u, t, wr, wc, fr, fq); }
        { EPM_LANE(); f32x4 G[2][2];
          const float* g1 = (const float*)ka[gi1] + goff1;
#pragma unroll
          for (int bj = 0; bj < 2; ++bj) { G[bj][0] = *(const f32x4*)(g1 + col0 + bj * HALF); G[bj][1] = *(const f32x4*)(g1 + col0 + bj * HALF + 4); }
#pragma unroll
          for (int ai = 0; ai < 2; ++ai) {
            u32x4 xw4[4][2];
#pragma unroll
            for (int m = 0; m < 4; ++m) { const size_t R = (size_t)u.pm * BM + ai * HALF + wr * 64 + m * 16 + fr; const bf16_t* xr = (const bf16_t*)(xrow + R * 2048);
#pragma unroll
                for (int bj = 0; bj < 2; ++bj) xw4[m][bj] = *(const u32x4*)(xr + col0 + bj * HALF); }
#pragma unroll
            for (int m = 0; m < 4; ++m) {
                float s = 0.f; const float ri = rinv[ai][m];
#pragma unroll
                for (int bj = 0; bj < 2; ++bj) { const unsigned w[4] = {xw4[m][bj].x, xw4[m][bj].y, xw4[m][bj].z, xw4[m][bj].w};
#pragma unroll
                    for (int n = 0; n < 2; ++n) { f32x4 v = acc[ai][bj][m][n]; const f32x4 gg = G[bj][n];
                        v[0] = __builtin_bit_cast(float, w[2 * n] << 16) + v[0] * ri * gg[0]; v[1] = __builtin_bit_cast(float, w[2 * n] & 0xffff0000u) + v[1] * ri * gg[1];
                        v[2] = __builtin_bit_cast(float, w[2 * n + 1] << 16) + v[2] * ri * gg[2]; v[3] = __builtin_bit_cast(float, w[2 * n + 1] & 0xffff0000u) + v[3] * ri * gg[3];
                        acc[ai][bj][m][n] = v; s += (v[0] * v[0] + v[1] * v[1]) + (v[2] * v[2] + v[3] * v[3]); } }
                p[ai][m] = s; }
            asm volatile("" ::: "memory"); }
        exchange(1, p, rinv, u, t, wr, wc, fr, fq); }
        EPM_LANE();
        if (last) {
#pragma unroll
            for (int ai = 0; ai < 2; ++ai)
#pragma unroll
                for (int m = 0; m < 4; ++m) { const size_t R = (size_t)u.pm * BM + ai * HALF + wr * 64 + m * 16 + fr; float* xo = xrow + R * 2048 + col0;
#pragma unroll
                    for (int bj = 0; bj < 2; ++bj) { *(f32x4*)(xo + bj * HALF) = acc[ai][bj][m][0]; *(f32x4*)(xo + bj * HALF + 4) = acc[ai][bj][m][1]; } }
        } else {
            f32x4 G[2][2]; const float* g2 = (const float*)ka[gi2] + goff2;
#pragma unroll
            for (int bj = 0; bj < 2; ++bj) { G[bj][0] = *(const f32x4*)(g2 + col0 + bj * HALF); G[bj][1] = *(const f32x4*)(g2 + col0 + bj * HALF + 4); }
            bf16_t* H = (bf16_t*)((unsigned char*)ka[19] + h_off);
#pragma unroll
            for (int ai = 0; ai < 2; ++ai)
#pragma unroll
                for (int m = 0; m < 4; ++m) { const size_t R = (size_t)u.pm * BM + ai * HALF + wr * 64 + m * 16 + fr; bf16_t* xo = dbg_x ? (bf16_t*)((unsigned char*)ka[19] + dbg_x) + R * 2048 + col0 : (bf16_t*)(xrow + R * 2048) + col0; bf16_t* ho = (dbg_h ? (bf16_t*)((unsigned char*)ka[19] + dbg_h) : H) + R * 2048 + col0;
                    const float s2 = rinv[ai][m];
#pragma unroll
                    for (int bj = 0; bj < 2; ++bj) { const f32x4 v0 = acc[ai][bj][m][0], v1 = acc[ai][bj][m][1]; const f32x4 a0 = G[bj][0], a1 = G[bj][1];
                        u32x4 w; w.x = cvt_pk_bf16(v0[0], v0[1]); w.y = cvt_pk_bf16(v0[2], v0[3]); w.z = cvt_pk_bf16(v1[0], v1[1]); w.w = cvt_pk_bf16(v1[2], v1[3]);
                        *(u32x4*)(xo + bj * HALF) = w;
                        w.x = cvt_pk_bf16(v0[0] * s2 * a0[0], v0[1] * s2 * a0[1]); w.y = cvt_pk_bf16(v0[2] * s2 * a0[2], v0[3] * s2 * a0[3]);
                        w.z = cvt_pk_bf16(v1[0] * s2 * a1[0], v1[1] * s2 * a1[1]); w.w = cvt_pk_bf16(v1[2] * s2 * a1[2], v1[3] * s2 * a1[3]);
                        *(u32x4*)(ho + bj * HALF) = w; } }
        }
#undef EPM_LANE
    }
};
template <class Epi, class Sched, bool ALIGN_EPI = false, bool SP2 = false>
__device__ __forceinline__ void gemm_phase(PG8_LAS unsigned char* lds, const Gemm g, const Sched& S, const Epi& E) {
    int tid_ = threadIdx.x; asm volatile("" : "+v"(tid_));
    const int tid = tid_, wid = __builtin_amdgcn_readfirstlane(tid >> 6), lane = tid & 63, wr = wid >> 2, wc = wid & 3, fr = lane & 15, fq = lane >> 4;
    const int K = g.K, nt = K / BK;
    unsigned voffA[2], voffB[2];
#pragma unroll
    for (int i = 0; i < 2; ++i) { int R, C; stage_rc(tid * 16 + i * 8192, R, C); const int Rb = Epi::PERM ? ((R & ~31) + perm32(R & 31)) : R;
        voffA[i] = (unsigned)(R * K + C) * 2u; voffB[i] = (unsigned)(Rb * K + C) * 2u; }
    const size_t kstep = (size_t)(BK * 2);
    const size_t hstep = (size_t)HALF * K * 2;
    const size_t tstep = 2 * hstep;
    const unsigned ldsw = (unsigned)wid * 1024u;
    const int aoff = lds_byte(wr * 64 + fr, fq * 8), boff = lds_byte(wc * 32 + fr, fq * 8);
#define PG8_SA(b, h) (((b) * 2 + (h)) * HTB)
#define PG8_SB(b, h) ((4 + (b) * 2 + (h)) * HTB)
#define PG8_STAGE(bufoff, gbase, voff) do { _Pragma("unroll") for (int _i = 0; _i < 2; ++_i) \
        __builtin_amdgcn_global_load_lds((const unsigned*)((const char*)(gbase) + (voff)[_i]), (PG8_LAS unsigned*)(lds + (bufoff) + ldsw + _i * 8192), 16, 0, 0); } while (0)
#define PG8_LDA(dst, b, h) do { _Pragma("unroll") for (int m = 0; m < 4; ++m) _Pragma("unroll") for (int k = 0; k < 2; ++k) dst[m][k] = *(const PG8_LAS bf16x8*)(lds + PG8_SA(b, h) + aoff + m * 2048 + k * 1024); } while (0)
#define PG8_LDB(dst, b, h) do { _Pragma("unroll") for (int n = 0; n < 2; ++n) _Pragma("unroll") for (int k = 0; k < 2; ++k) dst[n][k] = *(const PG8_LAS bf16x8*)(lds + PG8_SB(b, h) + boff + n * 2048 + k * 1024); } while (0)
#define PG8_MMA(ai, bj, At, Bt) do { __builtin_amdgcn_s_setprio(1); _Pragma("unroll") for (int m = 0; m < 4; ++m) _Pragma("unroll") for (int n = 0; n < 2; ++n) _Pragma("unroll") for (int k = 0; k < 2; ++k) \
        acc[ai][bj][m][n] = __builtin_amdgcn_mfma_f32_16x16x32_bf16(Bt[n][k], At[m][k], acc[ai][bj][m][n], 0, 0, 0); __builtin_amdgcn_s_setprio(0); } while (0)
#define PG8_WAIT_V(n) asm volatile("s_waitcnt vmcnt(" #n ")" ::: "memory")
#define PG8_WAIT_L(n) asm volatile("s_waitcnt lgkmcnt(" #n ")" ::: "memory")
#define PG8_BAR __builtin_amdgcn_s_barrier()
#define PG8_SCHED __builtin_amdgcn_sched_barrier(0)
    Unit cur, nxt; int ui = 0;
    if (!S.next(0, cur)) return;
    f32x4 acc[2][2][4][2];
#pragma unroll
    for (int a = 0; a < 2; ++a)
#pragma unroll
        for (int b = 0; b < 2; ++b)
#pragma unroll
            for (int m = 0; m < 4; ++m)
#pragma unroll
                for (int n = 0; n < 2; ++n) acc[a][b][m][n] = (f32x4){0.f, 0.f, 0.f, 0.f};
    bf16x8 At[4][2], B0[2][2], B1[2][2];
    const char* cA = (const char*)g.A + (size_t)cur.pm * tstep; const char* cB = (const char*)g.Bt + (size_t)cur.pn * tstep;
    S.a_ready(cur);
    if constexpr (SP2) {
        PG8_STAGE(PG8_SB(0, 0), cB, voffB); PG8_STAGE(PG8_SB(0, 1), cB + hstep, voffB); PG8_STAGE(PG8_SA(0, 0), cA, voffA); PG8_STAGE(PG8_SA(0, 1), cA + hstep, voffA);
        if (wr == 1) PG8_BAR;
        PG8_WAIT_V(2); PG8_BAR;
        PG8_STAGE(PG8_SB(1, 0), cB + kstep, voffB); PG8_STAGE(PG8_SA(1, 0), cA + kstep, voffA); PG8_STAGE(PG8_SB(1, 1), cB + hstep + kstep, voffB);
        PG8_WAIT_V(6); PG8_BAR;
    } else {
        PG8_STAGE(PG8_SB(0, 0), cB, voffB); PG8_STAGE(PG8_SA(0, 0), cA, voffA); PG8_STAGE(PG8_SB(0, 1), cB + hstep, voffB); PG8_STAGE(PG8_SA(0, 1), cA + hstep, voffA);
        if (wr == 1) PG8_BAR;
        PG8_WAIT_V(4); PG8_BAR;
        PG8_STAGE(PG8_SB(1, 0), cB + kstep, voffB); PG8_STAGE(PG8_SA(1, 0), cA + kstep, voffA); PG8_STAGE(PG8_SB(1, 1), cB + hstep + kstep, voffB);
        PG8_WAIT_V(6); PG8_BAR;
    }
    for (;;) {
        const bool has_next = S.next(ui + 1, nxt);
        const char* nA = has_next ? (const char*)g.A + (size_t)nxt.pm * tstep : cA; const char* nB = has_next ? (const char*)g.Bt + (size_t)nxt.pn * tstep : cB;
        for (int t = 0; t < nt; t += 2) {
            const bool last = (t == nt - 2);
            const char* a1 = cA + (size_t)(t + 1) * kstep;
            const char* a2 = last ? nA : cA + (size_t)(t + 2) * kstep; const char* b2 = last ? nB : cB + (size_t)(t + 2) * kstep;
            const char* a3 = a2 + kstep; const char* b3 = b2 + kstep;
            if (last && has_next) S.a_ready(nxt);
            if constexpr (SP2) {
            PG8_LDB(B0, 0, 0); PG8_LDB(B1, 0, 1); PG8_SCHED; PG8_LDA(At, 0, 0); PG8_STAGE(PG8_SA(1, 1), a1 + hstep, voffA);
            PG8_WAIT_V(8); PG8_WAIT_L(0); PG8_BAR; PG8_MMA(0, 0, At, B0); PG8_MMA(0, 1, At, B1); PG8_BAR; PG8_SCHED;
            PG8_LDA(At, 0, 1); PG8_STAGE(PG8_SB(0, 0), b2, voffB); PG8_STAGE(PG8_SB(0, 1), b2 + hstep, voffB); PG8_STAGE(PG8_SA(0, 0), a2, voffA);
            PG8_WAIT_V(8); PG8_WAIT_L(0); PG8_BAR; PG8_MMA(1, 0, At, B0); PG8_MMA(1, 1, At, B1); PG8_BAR; PG8_SCHED;
            PG8_LDB(B0, 1, 0); PG8_LDB(B1, 1, 1); PG8_SCHED; PG8_LDA(At, 1, 0); PG8_STAGE(PG8_SA(0, 1), a2 + hstep, voffA);
            PG8_WAIT_V(8); PG8_WAIT_L(0); PG8_BAR; PG8_MMA(0, 0, At, B0); PG8_MMA(0, 1, At, B1); PG8_BAR; PG8_SCHED;
            PG8_LDA(At, 1, 1); PG8_STAGE(PG8_SB(1, 0), b3, voffB); PG8_STAGE(PG8_SB(1, 1), b3 + hstep, voffB); PG8_STAGE(PG8_SA(1, 0), a3, voffA);
            PG8_WAIT_V(8); PG8_WAIT_L(0); PG8_BAR; PG8_MMA(1, 0, At, B0); PG8_MMA(1, 1, At, B1); PG8_BAR; PG8_SCHED;
            } else {
            PG8_LDB(B0, 0, 0); PG8_SCHED; PG8_LDA(At, 0, 0); PG8_STAGE(PG8_SA(1, 1), a1 + hstep, voffA);
            PG8_WAIT_L(8); PG8_BAR; PG8_WAIT_L(0); PG8_MMA(0, 0, At, B0); PG8_BAR; PG8_SCHED;
            PG8_LDB(B1, 0, 1); PG8_STAGE(PG8_SB(0, 0), b2, voffB);
            PG8_BAR; PG8_WAIT_L(0); PG8_MMA(0, 1, At, B1); PG8_BAR;
            PG8_LDA(At, 0, 1); PG8_STAGE(PG8_SA(0, 0), a2, voffA);
            PG8_BAR; PG8_WAIT_L(0); PG8_MMA(1, 0, At, B0); PG8_BAR; PG8_SCHED;
            PG8_STAGE(PG8_SB(0, 1), b2 + hstep, voffB);
            PG8_WAIT_V(6); PG8_BAR; PG8_MMA(1, 1, At, B1); PG8_BAR;
            PG8_LDB(B0, 1, 0); PG8_SCHED; PG8_LDA(At, 1, 0); PG8_STAGE(PG8_SA(0, 1), a2 + hstep, voffA);
            PG8_WAIT_L(8); PG8_BAR; PG8_WAIT_L(0); PG8_MMA(0, 0, At, B0); PG8_BAR; PG8_SCHED;
            PG8_LDB(B1, 1, 1); PG8_STAGE(PG8_SB(1, 0), b3, voffB);
            PG8_BAR; PG8_WAIT_L(0); PG8_MMA(0, 1, At, B1); PG8_BAR;
            PG8_LDA(At, 1, 1); PG8_STAGE(PG8_SA(1, 0), a3, voffA);
            PG8_BAR; PG8_WAIT_L(0); PG8_MMA(1, 0, At, B0); PG8_BAR; PG8_SCHED;
            PG8_STAGE(PG8_SB(1, 1), b3 + hstep, voffB);
            PG8_WAIT_V(6); PG8_BAR; PG8_MMA(1, 1, At, B1); PG8_BAR;
            }
        }
        if constexpr (ALIGN_EPI) { if (wr == 0) PG8_BAR; }
        if constexpr (!Epi::AFTER_DRAIN) { E(acc, cur, wr, wc, fr, fq); S.done(cur); }
        if (!has_next) break;
#pragma unroll
        for (int a = 0; a < 2; ++a)
#pragma unroll
            for (int b = 0; b < 2; ++b)
#pragma unroll
                for (int m = 0; m < 4; ++m)
#pragma unroll
                    for (int n = 0; n < 2; ++n) acc[a][b][m][n] = (f32x4){0.f, 0.f, 0.f, 0.f};
        cur = nxt; cA = nA; cB = nB; ++ui;
        if constexpr (ALIGN_EPI) { if (wr == 1) PG8_BAR; }
    }
    PG8_WAIT_V(0);
    if constexpr (!ALIGN_EPI) { if (wr == 0) PG8_BAR; }
    PG8_BAR;
    if constexpr (Epi::AFTER_DRAIN) { E.fused(acc, cur, wr, wc, fr, fq, lds, wid, lane); S.done(cur); }
#undef PG8_SA
#undef PG8_SB
#undef PG8_STAGE
#undef PG8_LDA
#undef PG8_LDB
#undef PG8_MMA
#undef PG8_WAIT_V
#undef PG8_WAIT_L
#undef PG8_BAR
#undef PG8_SCHED
}
}
#define LAS __attribute__((address_space(3)))
#define XB_TMO      128
#define XB_XCNT(j)  (256  + 64 * (j))
#define XB_XSUB(j)  (1280 + 64 * (j))
#define XB_XGEN(j)  (2304 + 64 * (j))
#define XB_TOP      3328
#define XB_TOPGEN   3392
#define XCD_BAR_WORDS 3456
#define XB_SPIN_CAP (1u << 18)

__device__ __forceinline__ unsigned xb_ld(unsigned* p)              { return __hip_atomic_load(p, __ATOMIC_RELAXED, __HIP_MEMORY_SCOPE_AGENT); }
__device__ __forceinline__ unsigned xb_add(unsigned* p, unsigned v) { return __hip_atomic_fetch_add(p, v, __ATOMIC_RELAXED, __HIP_MEMORY_SCOPE_AGENT); }
__device__ __forceinline__ unsigned xb_xcc_id() { return (unsigned)__builtin_amdgcn_s_getreg((3 << 11) | 20) & 0xFu; }
#define XB_SPIN(cond, bar) do { unsigned _sp = 0; while (cond) { __builtin_amdgcn_s_sleep(1); \
    if ((++_sp & 255u) == 0u) { if (xb_ld(&(bar)[XB_TMO])) break; if (_sp > XB_SPIN_CAP) { atomicAdd(&(bar)[XB_TMO], 1u); break; } } } } while (0)

struct XcdBarrier {
    unsigned* bar; unsigned x;
    volatile LAS unsigned* st;
};

__device__ __forceinline__ XcdBarrier xcd_barrier_post(unsigned* bar, volatile LAS unsigned* st) {
    XcdBarrier b; b.bar = bar; b.x = xb_xcc_id(); b.st = st;
    if (threadIdx.x == 0) (void)xb_add(&bar[XB_XCNT(b.x)], 1u);
    return b;
}
__device__ __forceinline__ void xcd_barrier_complete(unsigned* bar, unsigned x, unsigned& nloc, unsigned& nx) {
    const unsigned G = gridDim.x * gridDim.y * gridDim.z;
    unsigned sum, cnt, mine, sp = 0u;
    for (;;) {
        sum = 0u; cnt = 0u; mine = 0u;
#pragma unroll
        for (unsigned j = 0; j < 16; ++j) { const unsigned c = xb_ld(&bar[XB_XCNT(j)]); sum += c; cnt += (c > 0u) ? 1u : 0u; mine = (j == x) ? c : mine; }
        if (sum == G) break;
        __builtin_amdgcn_s_sleep(1);
        if ((++sp & 255u) == 0u) { if (xb_ld(&bar[XB_TMO])) break; if (sp > XB_SPIN_CAP) { atomicAdd(&bar[XB_TMO], 1u); break; } }
    }
    nloc = mine > 0u ? mine : 1u; nx = cnt > 0u ? cnt : 1u;
}

__device__ __forceinline__ void xcd_barrier(const XcdBarrier& b) {
    asm volatile("s_waitcnt vmcnt(0)" ::: "memory");
    __syncthreads();
    if (threadIdx.x == 0) {
        unsigned* bar = b.bar;
        __builtin_amdgcn_s_waitcnt(0);
        unsigned nloc = b.st[0], nx = b.st[1];
        if (nloc == 0u) { xcd_barrier_complete(bar, b.x, nloc, nx); b.st[0] = nloc; b.st[1] = nx; }
        const unsigned old = xb_add(&bar[XB_XSUB(b.x)], 1u);
        const unsigned gen = old / nloc;
        if (old + 1u == (gen + 1u) * nloc) {
            __builtin_amdgcn_fence(__ATOMIC_RELEASE, "agent");
            asm volatile("s_waitcnt vmcnt(0)" ::: "memory");
            const unsigned og = xb_add(&bar[XB_TOP], 1u);
            const unsigned tg = og / nx;
            if (og + 1u == (tg + 1u) * nx) xb_add(&bar[XB_TOPGEN], 1u);
            else XB_SPIN(xb_ld(&bar[XB_TOPGEN]) == tg, bar);
            __builtin_amdgcn_fence(__ATOMIC_ACQUIRE, "agent");
            xb_add(&bar[XB_XGEN(b.x)], 1u);
            asm volatile("s_waitcnt vmcnt(0)" ::: "memory");
        } else {
            XB_SPIN(xb_ld(&bar[XB_XGEN(b.x)]) == gen, bar);
            __builtin_amdgcn_fence(__ATOMIC_ACQUIRE, "agent");
            asm volatile("s_waitcnt vmcnt(0)" ::: "memory");
        }
    }
    __syncthreads();
}
constexpr int DM = 2048, DEPTH = 4, NH = 8, HD = 128, DFF = 5632, NUP = 2 * DFF;
constexpr int INC = 7200, INP = 7424;
constexpr int TG = 65536, NGRP = 1, THALF = 32768;
#define EPS (oc(1e-6f))
constexpr int NWAVES = 8, NTHR = 512;
constexpr size_t MiB = 1u << 20;
constexpr size_t WS_CTL = 0, CTL_ZERO_BYTES = 128 * 1024;
constexpr int CW_XCH = 16384;
constexpr size_t WS_BIAS = 512 * 1024;
constexpr size_t WS_WIN = 1 * MiB, WS_WOUT = 30 * MiB, WS_WUP = 38 * MiB, WS_WDN = 82 * MiB;
constexpr size_t WS_H = 104 * MiB;
constexpr size_t WS_QKVA = 360 * MiB;
constexpr size_t WS_QKVD = 744 * MiB;
constexpr size_t WS_Z = 1128 * MiB;
constexpr size_t WS_GATES = 1256 * MiB;
constexpr size_t WS_BG = 1264 * MiB;
constexpr size_t WS_QKVN = 1272 * MiB;
constexpr size_t WS_OF = 1656 * MiB, WS_OB = 1784 * MiB;
constexpr size_t WS_MIX = WS_QKVN;
constexpr size_t WS_MIXED = WS_QKVA;
constexpr size_t WS_ATTP = WS_QKVD;
constexpr size_t WS_ATTML = 1912 * MiB;
constexpr size_t WS_GACT = 360 * MiB;
constexpr size_t WS_EDGE = 1128 * MiB;
constexpr size_t WS_F = 1272 * MiB;
__host__ __device__ __forceinline__ constexpr size_t ws_h(int) { return WS_H; }
constexpr size_t WS_SC = 1924 * MiB;
constexpr size_t WS_XCH = 1936 * MiB;
constexpr size_t WS_END = 1941 * MiB;
constexpr int CW_BAR = 1024;
constexpr int CW_ATTQ = 8192;
constexpr int RING_BYTES = 131072, LDS_BYTES = 163840, MISC_OFF = LDS_BYTES - 512;

#define GAS __attribute__((address_space(1)))
typedef unsigned short bf16;
typedef unsigned v4u __attribute__((ext_vector_type(4)));
typedef unsigned v2u __attribute__((ext_vector_type(2)));
typedef float f32x4 __attribute__((ext_vector_type(4)));
#define DI __device__ __forceinline__
DI int otid() { int t = threadIdx.x; asm volatile("" : "+v"(t)); return t; }
DI int obid() { int b = blockIdx.x; asm volatile("" : "+s"(b)); return b; }
DI float oc(float c) { asm volatile("" : "+v"(c)); return c; }
DI float shx(float v, int m) { return __builtin_bit_cast(float, __builtin_amdgcn_ds_bpermute(((otid() & 63) ^ m) << 2, __builtin_bit_cast(int, v))); }
DI void dma16(const void* g, LAS void* l) {
    asm volatile("s_mov_b32 m0, %1\n\ts_nop 0\n\tglobal_load_lds_dwordx4 %0, off" :: "v"(g), "s"((unsigned)(size_t)l) : "memory", "m0"); }
DI void dma16s(const void* sbase, unsigned voff, LAS void* l) {
    asm volatile("s_mov_b32 m0, %2\n\ts_nop 0\n\tglobal_load_lds_dwordx4 %0, %1" :: "v"(voff), "s"(sbase), "s"((unsigned)(size_t)l) : "memory", "m0"); }
template <int N> DI float row_ror(float x) { return __builtin_bit_cast(float, __builtin_amdgcn_mov_dpp(__builtin_bit_cast(int, x), 0x120 + N, 0xf, 0xf, true)); }
DI void plswap16(float& a, float& b) { asm volatile("s_nop 1\n\tv_permlane16_swap_b32 %0, %1\n\ts_nop 1" : "+v"(a), "+v"(b)); }
DI void plswap32(float& a, float& b) { asm volatile("s_nop 1\n\tv_permlane32_swap_b32 %0, %1\n\ts_nop 1" : "+v"(a), "+v"(b)); }
DI float xr_max(float x) { float a = x, b = x; plswap16(a, b); x = fmaxf(a, b); a = x; b = x; plswap32(a, b); return fmaxf(a, b); }
DI float xr_sum(float x) { float a = x, b = x; plswap16(a, b); x = a + b; a = x; b = x; plswap32(a, b); return a + b; }
DI float bf2f(unsigned v) { return __uint_as_float(v << 16); }
DI float bflo(unsigned w) { return __uint_as_float(w << 16); }
DI float bfhi(unsigned w) { return __uint_as_float(w & 0xffff0000u); }
typedef __bf16 bf16x2v __attribute__((ext_vector_type(2)));
typedef float f32x2v __attribute__((ext_vector_type(2)));
DI unsigned cvtpk(float lo, float hi) { return __builtin_bit_cast(unsigned, __builtin_convertvector((f32x2v){lo, hi}, bf16x2v)); }
DI unsigned pk2(float lo, float hi) { return cvtpk(lo, hi); }
DI unsigned f2bf(float f) { return cvtpk(f, 0.f) & 0xffffu; }
DI float wave_sum(float v) {
#pragma unroll
    for (int o = 1; o < 64; o <<= 1) v += shx(v, o);
    return v;
}
DI float siluf(float x) { return x / (1.f + __expf(-x)); }
DI size_t grow(int, int r) { return (size_t)r; }
DI void seq_of(int r, int& s0, int& L) { if (r < 32768) { s0 = r & ~4095; L = 4096; } else { s0 = 32768 + ((r - 32768) & ~8191); L = 8192; } }

struct Args { const float* in[18]; float* out; unsigned char* ws; int s_lo, s_hi; };
typedef const __attribute__((address_space(4))) Args CArgs;

DI void ph_bias(const float* rel_bias, float* tab) {
    const int i = obid() * NTHR + otid();
    if (i < 3 * 129 * 8) {
        const int br = i / (129 * 8), h = (i / 129) & 7, j = i % 129 - 64, d = br == 0 ? 1 : (br == 1 ? 4 : 16);
        const int rel = j * d, n = rel < 0 ? -rel : rel, base = rel > 0 ? 16 : 0;
        const float nf = (float)(n > 1 ? n : 1);
        int large = 8 + (int)(__builtin_amdgcn_logf(nf * 0.125f) * oc(8.f / 7.f)); large = large < 15 ? large : 15;
        const int bucket = base + (n < 8 ? n : large);
        tab[i] = rel_bias[bucket * 8 + h];
    }
}
DI void transpose_item(const float* W, int K, int N, bf16* WT, LAS float* scr, int item, int lane, int nscale, float scale, bool gatemap = false) {
    const int nblk = N / 32, kb = item / nblk, nb = item % nblk, k0 = 64 * kb, n0 = 32 * nb;
    int d0 = n0; if (gatemap) { const int ch = n0 >= DFF ? n0 - DFF : n0; d0 = 256 * (ch >> 7) + (n0 >= DFF ? 128 : 0) + (ch & 127); }
    const float sc = (n0 < nscale) ? scale : 1.f;
#pragma unroll 8
    for (int i = 0; i < 32; ++i) { const int kk = 2 * i + (lane >> 5); scr[kk * 33 + (lane & 31)] = W[(size_t)(k0 + kk) * N + n0 + (lane & 31)] * sc; }
    asm volatile("s_waitcnt lgkmcnt(0)" ::: "memory");
    const int c = lane & 7;
#pragma unroll
    for (int j = 0; j < 4; ++j) { const int n = (lane >> 3) + 8 * j; const LAS float* s = scr + (8 * c) * 33 + n;
        v4u o; o.x = pk2(s[0 * 33], s[1 * 33]); o.y = pk2(s[2 * 33], s[3 * 33]); o.z = pk2(s[4 * 33], s[5 * 33]); o.w = pk2(s[6 * 33], s[7 * 33]);
        *(v4u*)(WT + (size_t)(d0 + n) * K + k0 + 8 * c) = o; }
    asm volatile("s_waitcnt lgkmcnt(0)" ::: "memory");
}
DI void ph_weights(CArgs& a, int l, LAS unsigned char* lds) {
    const int tid = otid(), lane = tid & 63, wave = __builtin_amdgcn_readfirstlane(tid >> 6);
    LAS float* scr = (LAS float*)(lds + wave * 16384);
    const int gw = obid() * NWAVES + wave, NGW = gridDim.x * NWAVES;
    const float* Win = a.in[4] + (size_t)l * DM * INC; const float* Wout = a.in[10] + (size_t)l * DM * DM;
    const float* Wup = a.in[13] + (size_t)l * DM * NUP; const float* Wdn = a.in[16] + (size_t)l * DFF * DM;
    bf16* Tin = (bf16*)(a.ws + WS_WIN); bf16* Tout = (bf16*)(a.ws + WS_WOUT); bf16* Tup = (bf16*)(a.ws + WS_WUP); bf16* Tdn = (bf16*)(a.ws + WS_WDN);
    constexpr int I_IN = (DM / 64) * (INC / 32), I_OUT = (DM / 64) * (DM / 32), I_UP = (DM / 64) * (NUP / 32), I_DN = (DFF / 64) * (DM / 32);
    for (int it = gw; it < I_IN + I_OUT + I_UP + I_DN; it += NGW) {
        int r = it;
        if (r < I_IN) { transpose_item(Win, DM, INC, Tin, scr, r, lane, 1024, oc(0.08838834764831845f)); continue; } r -= I_IN;
        if (r < I_OUT) { transpose_item(Wout, DM, DM, Tout, scr, r, lane, 0, 1.f); continue; } r -= I_OUT;
        if (r < I_UP) { transpose_item(Wup, DM, NUP, Tup, scr, r, lane, 0, 1.f, true); continue; } r -= I_UP;
        transpose_item(Wdn, DFF, DM, Tdn, scr, r, lane, 0, 1.f);
    }
    v4u* z = (v4u*)(Tin + (size_t)INC * DM); const int nz = (INP - INC) * DM / 8;
    const unsigned z0 = (unsigned)otid() >> 31;
    for (int i = obid() * NTHR + tid; i < nz; i += gridDim.x * NTHR) z[i] = (v4u){z0, z0, z0, z0};
}
DI void load_xrow(CArgs& a, int l, size_t R, int lane, f32x4 (&v)[8]) {
    if (l == 0) { const f32x4* x = (const f32x4*)((int)R < 32768 ? a.in[0] + R * DM : a.in[1] + (R - 32768) * DM);
#pragma unroll
        for (int j = 0; j < 8; ++j) v[j] = x[lane + 64 * j]; }
    else { const v2u* x = (const v2u*)(a.out + R * DM);
#pragma unroll
        for (int j = 0; j < 8; ++j) { const v2u w = x[lane + 64 * j]; v[j] = (f32x4){bflo(w.x), bfhi(w.x), bflo(w.y), bfhi(w.y)}; } }
}
DI float sumsq8(const f32x4 (&v)[8]) { float s = 0.f;
#pragma unroll
    for (int j = 0; j < 8; ++j) s += (v[j].x * v[j].x + v[j].y * v[j].y) + (v[j].z * v[j].z + v[j].w * v[j].w);
    return s; }
DI void cvt_row(const v2u (&w)[8], f32x4 (&v)[8]) {
#pragma unroll
    for (int j = 0; j < 8; ++j) v[j] = (f32x4){bflo(w[j].x), bfhi(w[j].x), bflo(w[j].y), bfhi(w[j].y)}; }
DI void ld_row_bf16(const bf16* rowp, int lane, v2u (&w)[8]) { const v2u* p = (const v2u*)rowp;
#pragma unroll
    for (int j = 0; j < 8; ++j) w[j] = __builtin_nontemporal_load(p + lane + 64 * j); }
DI void st_row_bf16(bf16* rowp, int lane, const f32x4 (&v)[8], float sc, const f32x4* gain) { v2u* o = (v2u*)rowp;
#pragma unroll
    for (int j = 0; j < 8; ++j) { const f32x4 gg = gain[lane + 64 * j]; v2u w; w.x = cvtpk(v[j].x * sc * gg.x, v[j].y * sc * gg.y); w.y = cvtpk(v[j].z * sc * gg.z, v[j].w * sc * gg.w); o[lane + 64 * j] = w; } }
DI void ph_prenorm(CArgs& a, int l, int g) {
    const int lane = otid() & 63, wave = __builtin_amdgcn_readfirstlane(otid() >> 6), gw = obid() * NWAVES + wave, NGW = gridDim.x * NWAVES;
    const f32x4* gain = (const f32x4*)(a.in[3] + (size_t)l * DM); bf16* H = (bf16*)(a.ws + ws_h(g));
    for (int r = gw; r < TG; r += 2 * NGW) {
        const int r1 = r + NGW;
        f32x4 va[8], vb[8]; load_xrow(a, l, grow(g, r), lane, va); load_xrow(a, l, grow(g, r1), lane, vb);
        st_row_bf16(H + (size_t)r * DM, lane, va, rsqrtf(wave_sum(sumsq8(va)) * (1.f / DM) + EPS), gain);
        st_row_bf16(H + (size_t)r1 * DM, lane, vb, rsqrtf(wave_sum(sumsq8(vb)) * (1.f / DM) + EPS), gain);
        { v2u* xa_ = (v2u*)(a.out + grow(g, r) * DM); v2u* xb_ = (v2u*)(a.out + grow(g, r1) * DM);
#pragma unroll
          for (int j = 0; j < 8; ++j) { v2u w; w.x = cvtpk(va[j].x, va[j].y); w.y = cvtpk(va[j].z, va[j].w); xa_[lane + 64 * j] = w; w.x = cvtpk(vb[j].x, vb[j].y); w.y = cvtpk(vb[j].z, vb[j].w); xb_[lane + 64 * j] = w; } }
    }
}
template <int PV> DI void postmix_row(CArgs& a, int g, int r, size_t R, int lane, const v2u (&mw)[8], f32x4 (&x)[8], const f32x4* g1, const f32x4* g2) {
    f32x4 v[8]; cvt_row(mw, v);
    const float rinv = PV == 3 ? ((const float*)(a.ws + WS_XCH + 4 * MiB))[r] : rsqrtf(wave_sum(sumsq8(v)) * (1.f / DM) + EPS);
    v2u* xo = PV == 1 ? (v2u*)((bf16*)(a.ws + WS_QKVN) + R * DM) : (v2u*)(a.out + R * DM);
#pragma unroll
    for (int j = 0; j < 8; ++j) { const f32x4 gg = g1[lane + 64 * j]; x[j] = x[j] + v[j] * rinv * gg; v2u w; w.x = cvtpk(x[j].x, x[j].y); w.y = cvtpk(x[j].z, x[j].w); xo[lane + 64 * j] = w; }
    st_row_bf16((bf16*)(a.ws + ((PV == 1 || PV == 2) ? WS_QKVD : ws_h(g))) + (size_t)r * DM, lane, x, PV == 3 ? ((const float*)(a.ws + WS_XCH + 4 * MiB))[TG + r] : rsqrtf(wave_sum(sumsq8(x)) * (1.f / DM) + EPS), g2);
}
template <int PV> DI void ph_postmix(CArgs& a, int l, int g) {
    const int lane = otid() & 63, wave = __builtin_amdgcn_readfirstlane(otid() >> 6), gw = obid() * NWAVES + wave, NGW = gridDim.x * NWAVES;
    const f32x4* g1 = (const f32x4*)(a.in[11] + (size_t)l * DM); const f32x4* g2 = (const f32x4*)(a.in[12] + (size_t)l * DM);
    const bf16* MX = (const bf16*)(a.ws + WS_MIXED);
    for (int r = gw; r < TG; r += 2 * NGW) {
        const int r1 = r + NGW; const size_t R = grow(g, r), R1 = grow(g, r1);
        v2u ma[8], mb[8]; f32x4 xa[8], xb[8];
        ld_row_bf16(MX + (size_t)r * DM, lane, ma); load_xrow(a, l, R, lane, xa); ld_row_bf16(MX + (size_t)r1 * DM, lane, mb); load_xrow(a, l, R1, lane, xb);
        postmix_row<PV>(a, g, r, R, lane, ma, xa, g1, g2); postmix_row<PV>(a, g, r1, R1, lane, mb, xb, g1, g2);
    }
}
template <int PV> DI void postffn_row(CArgs& a, int l, int g, int r, size_t R, int lane, const v2u (&fw)[8], const v2u (&xw)[8], const f32x4* g1) {
    f32x4 v[8], x[8]; cvt_row(fw, v); cvt_row(xw, x);
    const float rinv = rsqrtf(wave_sum(sumsq8(v)) * (1.f / DM) + EPS);
#pragma unroll
    for (int j = 0; j < 8; ++j) { const f32x4 gg = g1[lane + 64 * j]; v[j] = x[j] + v[j] * rinv * gg; }
    if (l == DEPTH - 1) { f32x4* xo = PV ? (f32x4*)((float*)(a.ws + WS_QKVA) + R * DM) : (f32x4*)(a.out + R * DM);
#pragma unroll
        for (int j = 0; j < 8; ++j) xo[lane + 64 * j] = v[j]; }
    else { v2u* xo = PV ? (v2u*)((bf16*)(a.ws + WS_QKVA) + R * DM) : (v2u*)(a.out + R * DM);
#pragma unroll
        for (int j = 0; j < 8; ++j) { v2u w; w.x = cvtpk(v[j].x, v[j].y); w.y = cvtpk(v[j].z, v[j].w); xo[lane + 64 * j] = w; }
        st_row_bf16((bf16*)(a.ws + (PV ? WS_QKVD : ws_h(g))) + (size_t)r * DM, lane, v, rsqrtf(wave_sum(sumsq8(v)) * (1.f / DM) + EPS), (const f32x4*)(a.in[3] + (size_t)(l + 1) * DM)); }
}
template <int PV> DI void ph_postffn(CArgs& a, int l, int g) {
    const int lane = otid() & 63, wave = __builtin_amdgcn_readfirstlane(otid() >> 6), gw = obid() * NWAVES + wave, NGW = gridDim.x * NWAVES;
    const f32x4* g1 = (const f32x4*)(a.in[17] + (size_t)l * DM); const bf16* FB = (const bf16*)(a.ws + WS_F);
    for (int r = gw; r < TG; r += 2 * NGW) {
        const int r1 = r + NGW; const size_t R = grow(g, r), R1 = grow(g, r1);
        v2u fa[8], fb[8], xa[8], xb[8];
        ld_row_bf16(FB + (size_t)r * DM, lane, fa); ld_row_bf16((const bf16*)(a.out + R * DM), lane, xa); ld_row_bf16(FB + (size_t)r1 * DM, lane, fb); ld_row_bf16((const bf16*)(a.out + R1 * DM), lane, xb);
        postffn_row<PV>(a, l, g, r, R, lane, fa, xa, g1); postffn_row<PV>(a, l, g, r1, R1, lane, fb, xb, g1);
    }
}
DI void ph_attn_simple(CArgs& a, int l) {
    const int lane = otid() & 63, wave = __builtin_amdgcn_readfirstlane(otid() >> 6), gw = obid() * NWAVES + wave, NGW = gridDim.x * NWAVES;
    const int ks = lane >> 4, dg = lane & 15;
    const bf16* QA = (const bf16*)(a.ws + WS_QKVA); bf16* MIX = (bf16*)(a.ws + WS_MIX);
    const float* tab = (const float*)(a.ws + WS_BIAS); const float* gain = a.in[8] + (size_t)l * HD;
    float gn[8];
#pragma unroll
    for (int i = 0; i < 8; ++i) gn[i] = gain[dg * 8 + i];
    for (int task = gw; task < TG * NH; task += NGW) {
        const int r = task >> 3, h = task & 7; int s0, L; seq_of(r, s0, L); const int p = r - s0;
        float q[8]; { const v4u w = *(const v4u*)(QA + (size_t)r * 3072 + h * HD + dg * 8);
            q[0] = bflo(w.x); q[1] = bfhi(w.x); q[2] = bflo(w.y); q[3] = bfhi(w.y); q[4] = bflo(w.z); q[5] = bfhi(w.z); q[6] = bflo(w.w); q[7] = bfhi(w.w); }
        float m = -1e30f, den = 0.f, o[8];
#pragma unroll
        for (int i = 0; i < 8; ++i) o[i] = 0.f;
        for (int br = 0; br < 3; ++br) {
            const int d = br == 0 ? 1 : (br == 1 ? 4 : 16);
            for (int it = 0; it < 33; ++it) {
                const int j = -64 + 4 * it + ks, pos = p + j * d;
                const bool valid = (j <= 64) && pos >= 0 && pos < L;
                float part = 0.f; const bf16* krow = QA + (size_t)(s0 + (valid ? pos : p)) * 3072 + h * HD + dg * 8;
                if (valid) { const v4u w = *(const v4u*)(krow + 1024);
                    part = q[0] * bflo(w.x) + q[1] * bfhi(w.x) + q[2] * bflo(w.y) + q[3] * bfhi(w.y) + q[4] * bflo(w.z) + q[5] * bfhi(w.z) + q[6] * bflo(w.w) + q[7] * bfhi(w.w); }
                part += shx(part, 1); part += shx(part, 2); part += shx(part, 4); part += shx(part, 8);
                if (valid) {
                    const float s = part + tab[(br * 8 + h) * 129 + (j + 64)];
                    const float mn = fmaxf(m, s), sc = __expf(m - mn), pw = __expf(s - mn);
                    const v4u w = *(const v4u*)(krow + 2048);
                    den = den * sc + pw; m = mn;
                    o[0] = o[0] * sc + pw * bflo(w.x); o[1] = o[1] * sc + pw * bfhi(w.x); o[2] = o[2] * sc + pw * bflo(w.y); o[3] = o[3] * sc + pw * bfhi(w.y);
                    o[4] = o[4] * sc + pw * bflo(w.z); o[5] = o[5] * sc + pw * bfhi(w.z); o[6] = o[6] * sc + pw * bflo(w.w); o[7] = o[7] * sc + pw * bfhi(w.w);
                }
            }
        }
        float ma = fmaxf(m, shx(m, 16)); ma = fmaxf(ma, shx(ma, 32));
        const float wg = __expf(m - ma);
        den *= wg; den += shx(den, 16); den += shx(den, 32);
        const float inv = 1.f / den; float ss = 0.f;
#pragma unroll
        for (int i = 0; i < 8; ++i) { float v = o[i] * wg; v += shx(v, 16); v += shx(v, 32); o[i] = v * inv; ss += o[i] * o[i]; }
        ss += shx(ss, 1); ss += shx(ss, 2); ss += shx(ss, 4); ss += shx(ss, 8);
        const float rinv = rsqrtf(ss * (1.f / HD) + EPS);
        if (ks == 0) { v4u w; w.x = pk2(o[0] * rinv * gn[0], o[1] * rinv * gn[1]); w.y = pk2(o[2] * rinv * gn[2], o[3] * rinv * gn[3]);
            w.z = pk2(o[4] * rinv * gn[4], o[5] * rinv * gn[5]); w.w = pk2(o[6] * rinv * gn[6], o[7] * rinv * gn[7]);
            *(v4u*)(MIX + (size_t)r * DM + h * HD + dg * 8) = w; }
    }
}

typedef short bf16x8 __attribute__((ext_vector_type(8)));
typedef short s16x4 __attribute__((ext_vector_type(4)));
typedef float f32x16 __attribute__((ext_vector_type(16)));
#define MFMA16(a, b, c) __builtin_amdgcn_mfma_f32_16x16x32_bf16((a), (b), (c), 0, 0, 0)
#define MFMA32(a, b, c) __builtin_amdgcn_mfma_f32_32x32x16_bf16((a), (b), (c), 0, 0, 0)
constexpr int VP = 272;
constexpr int ATT_WAVE_LDS = 32 * VP + 576;
DI void ph_attn_mfma(CArgs& a, LAS unsigned char* lds) {
    const int lane = otid() & 63, wave = __builtin_amdgcn_readfirstlane(otid() >> 6), gw = obid() * NWAVES + wave, NGW = gridDim.x * NWAVES;
    const int h5 = lane >> 5, ql = lane & 31;
    const bf16* QA = (const bf16*)(a.ws + WS_QKVA);
    const float* tab = (const float*)(a.ws + WS_BIAS);
    LAS unsigned char* vl = lds + wave * ATT_WAVE_LDS; LAS float* bl = (LAS float*)(vl + 32 * VP);
    const int i16 = lane & 15, q4 = i16 >> 2, p4 = i16 & 3, blk = (lane >> 4) & 1;
    for (int task = gw; task < 3 * 8192; task += NGW) {
        const int br = task >> 13, rem = task & 8191, h = rem >> 10, bidx = rem & 1023;
        const int d = br == 0 ? 1 : (br == 1 ? 4 : 16);
        int s0, L, within; if (bidx < 512) { s0 = (bidx >> 7) * 4096; L = 4096; within = bidx & 127; } else { s0 = 16384 + ((bidx - 512) >> 8) * 8192; L = 8192; within = (bidx - 512) & 255; }
        const int nsub = L / d, nqb = nsub >> 5, res = within / nqb, qb = within % nqb;
        for (int i = lane; i < 129; i += 64) bl[i] = tab[(br * 8 + h) * 129 + i];
        const bf16* base = QA + (size_t)(s0 + res) * 3072 + h * HD + 8 * h5;
        bf16x8 qf[8];
        { const bf16* qp = base + (size_t)(32 * qb + ql) * d * 3072;
#pragma unroll
          for (int ks = 0; ks < 8; ++ks) qf[ks] = *(const bf16x8*)(qp + 16 * ks); }
        f32x16 S[5];
#pragma unroll
        for (int kb = 0; kb < 5; ++kb) {
#pragma unroll
            for (int i = 0; i < 16; ++i) S[kb][i] = 0.f;
            const int mk0 = 32 * (qb + kb - 2);
            if (mk0 >= 0 && mk0 < nsub) {
                const bf16* kp = base + 1024 + (size_t)(mk0 + ql) * d * 3072;
                bf16x8 kf[8];
#pragma unroll
                for (int ks = 0; ks < 8; ++ks) kf[ks] = *(const bf16x8*)(kp + 16 * ks);
#pragma unroll
                for (int ks = 0; ks < 8; ++ks) S[kb] = MFMA32(kf[ks], qf[ks], S[kb]);
            }
        }
        float m = -1e30f;
#pragma unroll
        for (int kb = 0; kb < 5; ++kb) { const int mk0 = 32 * (qb + kb - 2); const bool bv = (mk0 >= 0 && mk0 < nsub);
#pragma unroll
            for (int i = 0; i < 16; ++i) { const int idx = 32 * kb + (i & 3) + 8 * (i >> 2) + 4 * h5 - ql; const bool ok = bv && idx >= 0 && idx <= 128;
                const float v = ok ? S[kb][i] + bl[ok ? idx : 0] : -1e30f; S[kb][i] = v; m = fmaxf(m, v); } }
        m = fmaxf(m, shx(m, 32));
        float den = 0.f;
#pragma unroll
        for (int kb = 0; kb < 5; ++kb)
#pragma unroll
            for (int i = 0; i < 16; ++i) { const float v = S[kb][i]; const float p = v > -1e29f ? __expf(v - m) : 0.f; S[kb][i] = p; den += p; }
        den += shx(den, 32);
        f32x16 O[4];
#pragma unroll
        for (int db = 0; db < 4; ++db)
#pragma unroll
            for (int i = 0; i < 16; ++i) O[db][i] = 0.f;
#pragma unroll
        for (int kb = 0; kb < 5; ++kb) {
            const int mk0 = 32 * (qb + kb - 2);
            if (mk0 >= 0 && mk0 < nsub) {
                v4u vr[8];
#pragma unroll
                for (int it = 0; it < 8; ++it) { const int row = 4 * it + (lane >> 4);
                    vr[it] = *(const v4u*)(QA + (size_t)(s0 + res + (size_t)(mk0 + row) * d) * 3072 + 2048 + h * HD + 8 * (lane & 15)); }
#pragma unroll
                for (int it = 0; it < 8; ++it) { const int row = 4 * it + (lane >> 4); *(LAS v4u*)(vl + row * VP + 16 * (lane & 15)) = vr[it]; }
#pragma unroll
                for (int s = 0; s < 2; ++s) {
                    v4u pw; pw.x = cvtpk(S[kb][8 * s + 0], S[kb][8 * s + 1]); pw.y = cvtpk(S[kb][8 * s + 2], S[kb][8 * s + 3]); pw.z = cvtpk(S[kb][8 * s + 4], S[kb][8 * s + 5]); pw.w = cvtpk(S[kb][8 * s + 6], S[kb][8 * s + 7]);
                    const bf16x8 pf = __builtin_bit_cast(bf16x8, pw);
#pragma unroll
                    for (int db = 0; db < 4; ++db) {
                        const s16x4 lo = __builtin_amdgcn_ds_read_tr16_b64_v4i16((LAS s16x4*)(vl + (16 * s + 4 * h5 + q4) * VP + (32 * db + 16 * blk + 4 * p4) * 2));
                        const s16x4 hi = __builtin_amdgcn_ds_read_tr16_b64_v4i16((LAS s16x4*)(vl + (16 * s + 8 + 4 * h5 + q4) * VP + (32 * db + 16 * blk + 4 * p4) * 2));
                        const bf16x8 vf = __builtin_shufflevector(lo, hi, 0, 1, 2, 3, 4, 5, 6, 7);
                        O[db] = MFMA32(vf, pf, O[db]);
                    }
                }
            }
        }
        const float inv = 1.f / den; const size_t row = (size_t)(s0 + res) + (size_t)(32 * qb + ql) * d;
        bf16* op = (bf16*)(a.ws + WS_ATTP) + ((size_t)br * TG + row) * 1024 + h * HD + 4 * h5;
#pragma unroll
        for (int db = 0; db < 4; ++db)
#pragma unroll
            for (int i4 = 0; i4 < 4; ++i4) { v2u w; w.x = cvtpk(O[db][4 * i4] * inv, O[db][4 * i4 + 1] * inv); w.y = cvtpk(O[db][4 * i4 + 2] * inv, O[db][4 * i4 + 3] * inv);
                *(v2u*)(op + 32 * db + 8 * i4) = w; }
        if (h5 == 0) { float* ml = (float*)(a.ws + WS_ATTML) + (((size_t)br * TG + row) * 8 + h) * 2; *(f32x2v*)ml = (f32x2v){m, den}; }
    }
}
DI bf16x8 pack8(const f32x4 lo, const f32x4 hi) { v4u p; p.x = cvtpk(lo[0], lo[1]); p.y = cvtpk(lo[2], lo[3]); p.z = cvtpk(hi[0], hi[1]); p.w = cvtpk(hi[2], hi[3]); return __builtin_bit_cast(bf16x8, p); }

struct AttnTile { int br, h, d, s0, nsub, res, mq0; };
DI AttnTile attn_decode(int tile) {
    AttnTile T; T.h = tile / 1536; int r = tile - T.h * 1536, L, within;
    if (r < 768) { const int sq = r / 96, rr = r - sq * 96; T.s0 = sq * 4096; L = 4096; T.br = rr >> 5; within = rr & 31; }
    else { r -= 768; const int sq = r / 192, rr = r - sq * 192; T.s0 = 32768 + sq * 8192; L = 8192; T.br = rr >> 6; within = rr & 63; }
    T.d = 1 << (2 * T.br);
    const int lgd = 2 * T.br, lgn = (L == 4096 ? 5 : 6) - lgd; T.nsub = L >> lgd; T.res = within >> lgn; T.mq0 = (within & ((1 << lgn) - 1)) << 7; return T;
}
constexpr int NATT = 3 * NH * (TG / 128);
template <int AV> DI void ph_attn2(CArgs& a, LAS unsigned char* lds, int l, int g, int qset = 0) {
    const int t = otid(), lane = t & 63, wave = __builtin_amdgcn_readfirstlane(t >> 6), ql = lane & 15, g4 = lane >> 4, q4 = ql >> 2, p4 = ql & 3;
    LAS unsigned char* Ki = lds; LAS unsigned char* Vi = lds + 65536;
    LAS float* bl0 = (LAS float*)(lds + 131072 + 1024); LAS float* bl12 = (LAS float*)(lds + 131072 + 4096 + 8 * 2048);
    LAS int* tqw = (LAS int*)(lds + 131072 + 512);
    int cur_h = -1;
    const unsigned dmaL0 = (unsigned)(((lane & 15) ^ (2 * g4)) * 16), dmaL1 = dmaL0 ^ 128u;
    unsigned kL[4], vL[8];
#pragma unroll
    for (int ks = 0; ks < 4; ++ks) kL[ks] = (unsigned)(ql * 256 + (((4 * ks + g4) ^ (2 * (ql & 7))) * 16));
    { const int vr = 4 * g4 + q4;
#pragma unroll
      for (int db = 0; db < 8; ++db) vL[db] = (unsigned)(vr * 256 + (((2 * db + (p4 >> 1)) ^ (2 * (vr & 7))) * 16) + 8 * (p4 & 1)); }
    const bf16* QA = (const bf16*)(a.ws + WS_QKVA); const float* tab = (const float*)(a.ws + WS_BIAS);
    unsigned* cntb = (unsigned*)(a.ws + WS_CTL) + CW_ATTQ + 64 * 8 * (qset * 8 + l * NGRP + g);
    const int xme = (int)(xb_xcc_id() & 7u);
    constexpr int NPAIR = NATT / 2, N8 = NPAIR / 8;
    int xq = 0;
#define ATT_FETCH(raw_, q_) do { q_ = xq < 8 ? xq : 7; raw_ = (int)__hip_atomic_fetch_add(cntb + 64 * ((xme + q_) & 7), 1u, __ATOMIC_RELAXED, __HIP_MEMORY_SCOPE_AGENT); } while (0)
    auto resolve = [&](int raw, int q) -> int {
        if (raw < N8) return ((xme + q) & 7) * N8 + raw;
        for (int qq = (xq > q + 1 ? xq : q + 1); qq < 8; ++qq) { const int i = (int)__hip_atomic_fetch_add(cntb + 64 * ((xme + qq) & 7), 1u, __ATOMIC_RELAXED, __HIP_MEMORY_SCOPE_AGENT); if (i < N8) { xq = qq; return ((xme + qq) & 7) * N8 + i; } }
        xq = 8; return NPAIR; };
    int nxt = 0, nxtq = 0;
    if (t == 0) { int r0_, q0_; ATT_FETCH(r0_, q0_); tqw[0] = resolve(r0_, q0_); ATT_FETCH(nxt, nxtq); }
    __syncthreads();
    int tile = 2 * tqw[0];
#define ATT_IMG(T_, sec_, cofs, dst, en) do { const unsigned char* gb_ = (const unsigned char*)(QA + (size_t)((T_).s0 + (T_).res) * 3072 + (T_).h * HD) + (cofs); \
        const int lgd_ = 2 * (T_).br, kofs_ = (T_).mq0 - 64 + ((sec_) ? 128 : 0), i0_ = ((sec_) ? 4 : 8) * wave; \
        if (!(((T_).mq0 < 64) || ((T_).mq0 + 192 > (T_).nsub))) { const unsigned lrow_ = (unsigned)(g4 * 6144) << lgd_; const unsigned l0_ = lrow_ + dmaL0, l1_ = lrow_ + dmaL1; \
            _Pragma("unroll") for (int u = 0; u < 8; ++u) { if (!(sec_) || u < 4) { const int i = i0_ + u; const unsigned ub_ = (unsigned)((kofs_ + 4 * i) * 6144) << lgd_; \
                if (en) dma16s(gb_, ((u & 1) ? l1_ : l0_) + ub_, (dst) + i * 1024); } } } \
        else { _Pragma("unroll") for (int u = 0; u < 8; ++u) { if (!(sec_) || u < 4) { const int i = i0_ + u; int m = kofs_ + 4 * i + g4; m = m < 0 ? 0 : (m > (T_).nsub - 1 ? (T_).nsub - 1 : m); \
                if (en) dma16s(gb_, ((unsigned)(m * 6144) << lgd_) + ((u & 1) ? dmaL1 : dmaL0), (dst) + i * 1024); } } } } while (0)
#define ATT_ISSUE_KQ(T_, qdst, sec_) do { ATT_IMG(T_, sec_, 2048, Ki, true); \
        const bf16* qp_ = QA + (size_t)((T_).s0 + (T_).res) * 3072 + (T_).h * HD + (size_t)((T_).mq0 + 16 * wave + ql) * (T_).d * 3072 + 8 * g4; \
        _Pragma("unroll") for (int ks = 0; ks < 4; ++ks) qdst[ks] = *(const bf16x8*)(qp_ + 32 * ks); } while (0)
    bf16x8 qf[4];
    if (tile < NATT) { const AttnTile T0 = attn_decode(tile); ATT_ISSUE_KQ(T0, qf, 0); }
    { unsigned* dmy = (unsigned*)(a.ws + WS_CTL + 768 * 1024) + t;
#pragma unroll
      for (int i = 0; i < 5; ++i) __builtin_nontemporal_store(0u, dmy + 512 * i); }
    while (tile < NATT) {
        const AttnTile T = attn_decode(tile);
        const int br = T.br, h = T.h, d = T.d, s0 = T.s0, nsub = T.nsub, res = T.res, mq0 = T.mq0;
        if (h != cur_h) { cur_h = h;
            for (int i = t; i < 3 * 4 * 192; i += NTHR) { const int b = i / 768, ii = i - b * 768, c = ii / 192, j = ii % 192, k = j + c - 16;
                (b == 0 ? bl0 : bl12 + (b - 1) * 768)[ii] = (k >= 0 && k < 129) ? tab[(b * 8 + h) * 129 + k] : -1e30f; } }
        const LAS float* bl = br == 0 ? bl0 : bl12 + (br - 1) * 768;
        const int sec = tile & 1;
        if (t == 0 && sec) tqw[1] = resolve(nxt, nxtq);
        const bf16* sbase = QA + (size_t)(s0 + res) * 3072 + h * HD;
        asm volatile("s_waitcnt vmcnt(5) lgkmcnt(0)" : "+v"(qf[0]), "+v"(qf[1]), "+v"(qf[2]), "+v"(qf[3]) :: "memory"); __builtin_amdgcn_s_barrier(); asm volatile("" ::: "memory");
        int nn2 = 0, nn2q = 0; if (t == 0 && sec) ATT_FETCH(nn2, nn2q);
        ATT_IMG(T, sec, 4096, Vi, !(AV & 16));
        const int ntile = sec ? 2 * tqw[1] : tile + 1;
        const int roff = sec ? 128 : 0;
        const bool edge_tile = (mq0 < 64) || (mq0 + 192 > nsub);
        const size_t qrow = (size_t)(s0 + res) + (size_t)(mq0 + 16 * wave + ql) * d;
        f32x4 S[9];
        bf16x8 ka[2][4];
#define LDK4(dst, kb) do { const unsigned rb_ = (unsigned)(((16 * (wave + (kb)) + roff) & 255) * 256); _Pragma("unroll") for (int ks = 0; ks < 4; ++ks) dst[ks] = *(const LAS bf16x8*)(Ki + rb_ + kL[ks]); } while (0)
        LDK4(ka[0], 0);
#pragma unroll
        for (int kb = 0; kb < 9; ++kb) {
            if (kb + 1 < 9) LDK4(ka[(kb + 1) & 1], kb + 1);
            __builtin_amdgcn_sched_barrier(0);
            S[kb] = (f32x4){0.f, 0.f, 0.f, 0.f};
#pragma unroll
            for (int ks = 0; ks < 4; ++ks) if (!(AV & 1)) S[kb] = MFMA16(ka[kb & 1][ks], qf[ks], S[kb]);
            __builtin_amdgcn_sched_barrier(0);
        }
#undef LDK4
        float mx = -1e30f;
        { const int a0 = 4 * g4 - ql + 16, c = a0 & 3;
          const LAS float* bc = bl + 192 * c + (a0 - c);
          if (!edge_tile) {
#pragma unroll
            for (int kb = 0; kb < 9; ++kb) {
              const f32x4 b4 = (AV & 8) ? (f32x4){0.f, 0.f, 0.f, 0.f} : *(const LAS f32x4*)(bc + 16 * kb);
#pragma unroll
              for (int i = 0; i < 4; ++i) { const float v = S[kb][i] + b4[i]; S[kb][i] = v; mx = fmaxf(mx, v); } }
          } else {
            const int lo = 64 - mq0 - 16 * wave - 4 * g4; const unsigned rng = (unsigned)(nsub - 1);
#pragma unroll
            for (int kb = 0; kb < 9; ++kb) {
              const f32x4 b4 = (AV & 8) ? (f32x4){0.f, 0.f, 0.f, 0.f} : *(const LAS f32x4*)(bc + 16 * kb);
#pragma unroll
              for (int i = 0; i < 4; ++i) { const float sb = S[kb][i] + b4[i]; const float v = ((unsigned)(16 * kb + i - lo) <= rng) ? sb : -1e30f; S[kb][i] = v; mx = fmaxf(mx, v); } }
          } }
        mx = xr_max(mx);
        float den = 0.f;
        { const float mxs = -mx * 1.44269504f;
#pragma unroll
          for (int kb = 0; kb < 9; ++kb)
#pragma unroll
            for (int i = 0; i < 4; ++i) { if (!(AV & 2)) { const float p = __builtin_amdgcn_exp2f(__builtin_fmaf(S[kb][i], 1.44269504f, mxs)); S[kb][i] = p; den += p; } else den += 1.f; } }
        den = xr_sum(den);
        asm volatile("s_waitcnt vmcnt(0) lgkmcnt(0)" ::: "memory"); __builtin_amdgcn_s_barrier(); asm volatile("" ::: "memory");
        if (!(AV & 16) && ntile < NATT) { const AttnTile Tn = attn_decode(ntile); ATT_ISSUE_KQ(Tn, qf, (ntile & 1)); }
        f32x4 O[8];
#pragma unroll
        for (int db = 0; db < 8; ++db) O[db] = (f32x4){0.f, 0.f, 0.f, 0.f};
        s16x4 va[2][16];
#define LDV16(dst, s) do { const unsigned blo_ = (unsigned)(((16 * (wave + 2 * (s)) + roff) & 255) * 256), bhi_ = (2 * (s) + 1 < 9) ? (unsigned)(((16 * (wave + 2 * (s) + 1) + roff) & 255) * 256) : blo_; \
            _Pragma("unroll") for (int db = 0; db < 8; ++db) { \
                dst[2 * db] = __builtin_amdgcn_ds_read_tr16_b64_v4i16((LAS s16x4*)(Vi + blo_ + vL[db])); \
                dst[2 * db + 1] = __builtin_amdgcn_ds_read_tr16_b64_v4i16((LAS s16x4*)(Vi + bhi_ + vL[db])); } } while (0)
        LDV16(va[0], 0);
#pragma unroll
        for (int s = 0; s < 5; ++s) {
            if (s + 1 < 5) LDV16(va[(s + 1) & 1], s + 1);
            __builtin_amdgcn_sched_barrier(0);
            const bf16x8 Pf = pack8(S[2 * s], (2 * s + 1 < 9) ? S[2 * s + 1] : (f32x4){0.f, 0.f, 0.f, 0.f});
#pragma unroll
            for (int db = 0; db < 8; ++db) if (!(AV & 4)) O[db] = MFMA16(__builtin_shufflevector(va[s & 1][2 * db], va[s & 1][2 * db + 1], 0, 1, 2, 3, 4, 5, 6, 7), Pf, O[db]);
            __builtin_amdgcn_sched_barrier(0);
        }
#undef LDV16
        const float inv = 1.f / den;
        { LAS unsigned char* st = lds + 131072 + 4096 + wave * 2048;
          const size_t qrow_s = (size_t)(s0 + res) + (size_t)(mq0 + 16 * wave + (lane >> 2)) * d;
          bf16* op = (bf16*)(a.ws + (AV ? WS_QKVN : WS_ATTP)) + ((size_t)br * TG + qrow_s) * 1024 + h * HD + (lane & 3) * 16;
#pragma unroll
          for (int hf = 0; hf < 2; ++hf) { if (AV & 32) { asm volatile("" :: "v"(O[4 * hf]), "v"(O[4 * hf + 1]), "v"(O[4 * hf + 2]), "v"(O[4 * hf + 3])); continue; }
#pragma unroll
              for (int db = 0; db < 4; ++db) { const f32x4 o = O[4 * hf + db]; *(LAS v2u*)(st + ql * 128 + (16 * db + 4 * g4) * 2) = (v2u){cvtpk(o[0] * inv, o[1] * inv), cvtpk(o[2] * inv, o[3] * inv)}; }
              const v4u w0 = *(const LAS v4u*)(st + (lane >> 2) * 128 + (lane & 3) * 32), w1 = *(const LAS v4u*)(st + (lane >> 2) * 128 + (lane & 3) * 32 + 16);
              *(v4u*)(op + 64 * hf) = w0; *(v4u*)(op + 64 * hf + 8) = w1;
          } }
        { float* ml = (float*)(a.ws + (AV ? WS_GATES : WS_ATTML)) + (((size_t)br * TG + qrow) * 8 + h) * 2; *(f32x2v*)ml = (f32x2v){mx, den}; }
        tile = ntile; if (sec) { nxt = nn2; nxtq = nn2q; }
    }
#undef ATT_ISSUE_KQ
#undef ATT_IMG
#undef ATT_FETCH
    asm volatile("s_waitcnt vmcnt(0) lgkmcnt(0)" ::: "memory"); __builtin_amdgcn_s_barrier(); asm volatile("" ::: "memory");
}
DI void ph_attn_merge(CArgs& a, int l) {
    const int lane = otid() & 63, wave = __builtin_amdgcn_readfirstlane(otid() >> 6), gw = obid() * NWAVES + wave, NGW = gridDim.x * NWAVES;
    const bf16* AP = (const bf16*)(a.ws + WS_ATTP); const float* ML = (const float*)(a.ws + WS_ATTML); bf16* MIX = (bf16*)(a.ws + WS_MIX);
    const float* gain = a.in[8] + (size_t)l * HD + (lane & 7) * 16;
    float gn[16];
#pragma unroll
    for (int i = 0; i < 16; ++i) gn[i] = gain[i];
    const int h = lane >> 3;
    for (int r0 = gw; r0 < TG; r0 += 2 * NGW) {
        v4u pw[2][3][2]; f32x2v mlv[2][3];
#pragma unroll
        for (int rr = 0; rr < 2; ++rr) { const int r = r0 + rr * NGW;
#pragma unroll
            for (int b = 0; b < 3; ++b) { mlv[rr][b] = *(const f32x2v*)(ML + (((size_t)b * TG + r) * 8 + h) * 2);
                pw[rr][b][0] = *(const v4u*)(AP + ((size_t)b * TG + r) * 1024 + lane * 16); pw[rr][b][1] = *(const v4u*)(AP + ((size_t)b * TG + r) * 1024 + lane * 16 + 8); } }
#pragma unroll
        for (int rr = 0; rr < 2; ++rr) { const int r = r0 + rr * NGW;
            const float ma = fmaxf(mlv[rr][0].x, fmaxf(mlv[rr][1].x, mlv[rr][2].x));
            float w[3], ws = 0.f;
#pragma unroll
            for (int b = 0; b < 3; ++b) { w[b] = __expf(mlv[rr][b].x - ma) * mlv[rr][b].y; ws += w[b]; }
            const float inv = 1.f / ws;
            float o[16];
#pragma unroll
            for (int i = 0; i < 16; ++i) o[i] = 0.f;
#pragma unroll
            for (int b = 0; b < 3; ++b) { const float wb = w[b] * inv;
#pragma unroll
                for (int hf = 0; hf < 2; ++hf) { const v4u f = pw[rr][b][hf]; const unsigned fw[4] = {f.x, f.y, f.z, f.w};
#pragma unroll
                    for (int k = 0; k < 4; ++k) { o[hf * 8 + 2 * k] += wb * bflo(fw[k]); o[hf * 8 + 2 * k + 1] += wb * bfhi(fw[k]); } } }
            float ss = 0.f;
#pragma unroll
            for (int i = 0; i < 16; ++i) ss += o[i] * o[i];
            ss += shx(ss, 1); ss += shx(ss, 2); ss += shx(ss, 4);
            const float rinv = rsqrtf(ss * (1.f / HD) + EPS);
            unsigned wv[8];
#pragma unroll
            for (int k = 0; k < 8; ++k) wv[k] = pk2(o[2 * k] * rinv * gn[2 * k], o[2 * k + 1] * rinv * gn[2 * k + 1]);
            *(v4u*)(MIX + (size_t)r * DM + lane * 16) = (v4u){wv[0], wv[1], wv[2], wv[3]};
            *(v4u*)(MIX + (size_t)r * DM + lane * 16 + 8) = (v4u){wv[4], wv[5], wv[6], wv[7]};
        }
    }
}
DI void ph_dn_prep(CArgs& a, int l) {
    const int lane = otid() & 63, wave = __builtin_amdgcn_readfirstlane(otid() >> 6), gw = obid() * NWAVES + wave, NGW = gridDim.x * NWAVES;
    const bf16* RAW = (const bf16*)(a.ws + WS_QKVD); bf16* QN = (bf16*)(a.ws + WS_QKVN);
    const float* cw = a.in[5] + (size_t)l * 3 * 3072;
    constexpr int RS = 32, NSTRIP = TG / RS;
    for (int task = gw; task < NSTRIP * 6; task += NGW) {
        const int strip = task / 6, cgp = task % 6, c0 = cgp * 512 + lane * 8, which = c0 >> 10, r0 = strip * RS;
        int s0, L; seq_of(r0, s0, L);
        float w0[8], w1[8], w2[8];
#pragma unroll
        for (int i = 0; i < 8; ++i) { w0[i] = cw[c0 + i]; w1[i] = cw[3072 + c0 + i]; w2[i] = cw[6144 + c0 + i]; }
        const float qs = which == 0 ? oc(0.08838834764831845f) : 1.f;
        v4u prev = (v4u){0u, 0u, 0u, 0u}, cur;
        if (r0 > s0) prev = *(const v4u*)(RAW + (size_t)(r0 - 1) * 3072 + c0);
        cur = *(const v4u*)(RAW + (size_t)r0 * 3072 + c0);
        for (int rb = 0; rb < RS; rb += 8) {
            v4u nx[8];
#pragma unroll
            for (int k = 0; k < 8; ++k) { const int r = r0 + rb + k + 1; nx[k] = (r < s0 + L) ? *(const v4u*)(RAW + (size_t)r * 3072 + c0) : (v4u){0u, 0u, 0u, 0u}; }
#pragma unroll
            for (int k = 0; k < 8; ++k) {
                const unsigned a0[4] = {prev.x, prev.y, prev.z, prev.w}, a1[4] = {cur.x, cur.y, cur.z, cur.w}, a2[4] = {nx[k].x, nx[k].y, nx[k].z, nx[k].w};
                float y[8]; float ss = 0.f;
#pragma unroll
                for (int j = 0; j < 4; ++j) {
                    y[2 * j] = siluf(w0[2 * j] * bflo(a0[j]) + w1[2 * j] * bflo(a1[j]) + w2[2 * j] * bflo(a2[j]));
                    y[2 * j + 1] = siluf(w0[2 * j + 1] * bfhi(a0[j]) + w1[2 * j + 1] * bfhi(a1[j]) + w2[2 * j + 1] * bfhi(a2[j]));
                    ss += y[2 * j] * y[2 * j] + y[2 * j + 1] * y[2 * j + 1];
                }
                float sc = 1.f;
                if (which < 2) { ss += row_ror<8>(ss); ss += row_ror<4>(ss); ss += row_ror<2>(ss); ss += row_ror<1>(ss); sc = rsqrtf(ss + EPS) * qs; }
                *(v4u*)(QN + (size_t)(r0 + rb + k) * 3072 + c0) = (v4u){cvtpk(y[0] * sc, y[1] * sc), cvtpk(y[2] * sc, y[3] * sc), cvtpk(y[4] * sc, y[5] * sc), cvtpk(y[6] * sc, y[7] * sc)};
                prev = cur; cur = nx[k];
            }
        }
    }
    const float* GT = (const float*)(a.ws + WS_GATES); float* BG = (float*)(a.ws + WS_BG);
    const float* alog = a.in[6] + l * 16; const float* dtb = a.in[7] + l * 16;
    for (int i = obid() * NTHR + otid(); i < TG * 32; i += gridDim.x * NTHR) {
        const int c = i & 31; const float x = GT[i]; float y;
        if (c < 16) y = 1.f / (1.f + __expf(-x));
        else { const float t = x + dtb[c - 16]; const float sp = t > 20.f ? t : __builtin_amdgcn_logf(1.f + __expf(t)) * oc(0.69314718f); y = -__expf(alog[c - 16]) * sp; }
        BG[i] = y;
    }
}
DI void ph_dn_scan_simple(CArgs& a, LAS unsigned char* lds) {
    const int t = otid(), c = t & 127, kg = __builtin_amdgcn_readfirstlane(t >> 7);
    LAS float* kq = (LAS float*)lds;
    LAS float* red = (LAS float*)(lds + 2048);
    LAS float* red2 = (LAS float*)(lds + 2048 + 4096);
    const bf16* QN = (const bf16*)(a.ws + WS_QKVN); const float* BG = (const float*)(a.ws + WS_BG);
    for (int chain = obid(); chain < 96; chain += gridDim.x) {
        const int seq = chain >> 4, h = (chain >> 1) & 7, dir = chain & 1;
        const int s0 = seq < 4 ? seq * 4096 : 16384 + (seq - 4) * 8192, L = seq < 4 ? 4096 : 8192;
        bf16* O = (bf16*)(a.ws + (dir ? WS_OB : WS_OF));
        float S[32];
#pragma unroll
        for (int i = 0; i < 32; ++i) S[i] = 0.f;
        int row = s0 + (dir ? L - 1 : 0);
        float kq_r = 0.f, v_r, g_r, b_r;
        if (t < 256) kq_r = bf2f(QN[(size_t)row * 3072 + (t < 128 ? 1024 + h * HD + t : h * HD + (t - 128))]);
        v_r = bf2f(QN[(size_t)row * 3072 + 2048 + h * HD + c]); b_r = BG[(size_t)row * 32 + dir * 8 + h]; g_r = BG[(size_t)row * 32 + 16 + dir * 8 + h];
        int prow = row;
        for (int i = 0; i < L; ++i) {
            const int buf = i & 1; const int crow = row;
            if (t < 256) kq[buf * 256 + t] = kq_r;
            const float v = v_r, eg = __expf(g_r), beta = b_r;
            if (i + 1 < L) { row = s0 + (dir ? L - 2 - i : i + 1);
                if (t < 256) kq_r = bf2f(QN[(size_t)row * 3072 + (t < 128 ? 1024 + h * HD + t : h * HD + (t - 128))]);
                v_r = bf2f(QN[(size_t)row * 3072 + 2048 + h * HD + c]); b_r = BG[(size_t)row * 32 + dir * 8 + h]; g_r = BG[(size_t)row * 32 + 16 + dir * 8 + h]; }
            __syncthreads();
            if (i > 0 && kg == 0) { const LAS float* rr = red2 + (buf ^ 1) * 512; O[(size_t)prow * 1024 + h * HD + c] = (bf16)f2bf(rr[c] + rr[128 + c] + rr[256 + c] + rr[384 + c]); }
            const LAS float* kk = kq + buf * 256 + kg * 32; const LAS float* qq = kq + buf * 256 + 128 + kg * 32;
            float part = 0.f;
#pragma unroll
            for (int j = 0; j < 32; ++j) { S[j] *= eg; part += kk[j] * S[j]; }
            red[buf * 512 + kg * 128 + c] = part;
            __syncthreads();
            const LAS float* rr = red + buf * 512; const float tot = rr[c] + rr[128 + c] + rr[256 + c] + rr[384 + c];
            const float vn = beta * (v - tot); float op = 0.f;
#pragma unroll
            for (int j = 0; j < 32; ++j) { S[j] += kk[j] * vn; op += qq[j] * S[j]; }
            red2[buf * 512 + kg * 128 + c] = op;
            prow = crow;
        }
        __syncthreads();
        if (kg == 0) { const LAS float* rr = red2 + ((L - 1) & 1) * 512; O[(size_t)prow * 1024 + h * HD + c] = (bf16)f2bf(rr[c] + rr[128 + c] + rr[256 + c] + rr[384 + c]); }
        __syncthreads();
    }
}

constexpr int NITEM = (TG / 64) * NH * 2;
constexpr int TQ_ITEM = 3072;
__host__ __device__ constexpr int tri_off(int i) { return i == 0 ? 0 : 4 * (2 * ((i - 1) >> 2) * (((i - 1) >> 2) + 1) + ((i - 1) & 3) * (((i - 1) >> 2) + 1)); }
constexpr int SA_WAVE_LDS = 9216 + 4096 + 1024;
static_assert(8 * SA_WAVE_LDS <= MISC_OFF, "stage A LDS map");
DI f32x4 mm4(f32x4 acc, const f32x4 aop, const f32x4 x) {
#pragma unroll
    for (int e = 0; e < 4; ++e) acc = __builtin_amdgcn_mfma_f32_16x16x4f32(aop[e], x[e], acc, 0, 0, 0);
    return acc; }
DI void ph_dn_stageA(CArgs& a, LAS unsigned char* lds, int g) {
    const int lane = otid() & 63, wave = __builtin_amdgcn_readfirstlane(otid() >> 6), gw = obid() * NWAVES + wave, NGW = gridDim.x * NWAVES;
    LAS unsigned char* wl = lds + wave * SA_WAVE_LDS;
    LAS float* Ap = (LAS float*)wl; LAS unsigned short* stg = (LAS unsigned short*)wl; LAS float* Sb = (LAS float*)(wl + 9216);
    LAS float* sgcF = (LAS float*)(wl + 9216 + 4096); LAS float* sbtF = sgcF + 64; LAS float* sgcB = sgcF + 128; LAS float* sbtB = sgcF + 192;
    const bf16* QN = (const bf16*)(a.ws + WS_QKVN); const float* BG = (const float*)(a.ws + WS_BG);
    bf16* TQ = (bf16*)(a.ws + ws_h(g)); float* SC = (float*)(a.ws + WS_SC);
    for (int pair = gw; pair < NITEM / 2; pair += NGW) {
        const int h = pair & 7, row0 = (pair >> 3) * 64, itemF = pair * 2, itemB = pair * 2 + 1;
        int lo_ = lane; asm volatile("" : "+v"(lo_));
        const int n = lo_ & 15, g4 = lo_ >> 4;
        { const int rf = row0 + lane, rb = row0 + 63 - lane;
          const float gvF = BG[(size_t)rf * 32 + 16 + h], btF = BG[(size_t)rf * 32 + h], gvB = BG[(size_t)rb * 32 + 24 + h], btB = BG[(size_t)rb * 32 + 8 + h];
          float gcF = gvF, gcB = gvB;
#pragma unroll
          for (int off = 1; off < 64; off <<= 1) {
              const float tF = __builtin_bit_cast(float, __builtin_amdgcn_ds_bpermute(((lane - off) & 63) << 2, __builtin_bit_cast(int, gcF)));
              const float tB = __builtin_bit_cast(float, __builtin_amdgcn_ds_bpermute(((lane - off) & 63) << 2, __builtin_bit_cast(int, gcB)));
              if (lane >= off) { gcF += tF; gcB += tB; } }
          const float glF = __builtin_bit_cast(float, __builtin_amdgcn_readlane(__builtin_bit_cast(int, gcF), 63)), glB = __builtin_bit_cast(float, __builtin_amdgcn_readlane(__builtin_bit_cast(int, gcB), 63));
          sgcF[lane] = gcF; sbtF[lane] = btF; sgcB[lane] = gcB; sbtB[lane] = btB;
          float* scF = SC + (size_t)itemF * 192; scF[lane] = __expf(gcF); scF[64 + lane] = btF; scF[128 + lane] = __expf(glF - gcF);
          float* scB = SC + (size_t)itemB * 192; scB[lane] = __expf(gcB); scB[64 + lane] = btB; scB[128 + lane] = __expf(glB - gcB); }
        bf16x8 kf[4][4];
#pragma unroll
        for (int blk = 0; blk < 4; ++blk) { const int row = row0 + 16 * blk + n;
#pragma unroll
            for (int s = 0; s < 4; ++s) kf[blk][s] = *(const bf16x8*)(QN + (size_t)row * 3072 + 1024 + h * HD + 32 * s + 8 * g4); }
#pragma unroll
        for (int dirb = 0; dirb < 2; ++dirb) {
#pragma unroll
            for (int mb = 0; mb < 4; ++mb) {
                const int rb0 = 16 * mb + 4 * g4;
                const f32x4 gFr = *(const LAS f32x4*)(sgcF + rb0), bFr = *(const LAS f32x4*)(sbtF + rb0), gBr = *(const LAS f32x4*)(sgcB + 60 - rb0);
#pragma unroll
                for (int nb = 0; nb <= mb; ++nb) {
                    f32x4 c = (f32x4){0.f, 0.f, 0.f, 0.f};
#pragma unroll
                    for (int s = 0; s < 4; ++s) c = MFMA16(kf[mb][s], kf[nb][s], c);
                    const int cc = 16 * nb + n, ib = 63 - cc; const float gFc = sgcF[cc], gBc = sgcB[ib], bBc = sbtB[ib];
                    const int tob = tri_off(ib);
#pragma unroll
                    for (int i = 0; i < 4; ++i) { const int r = rb0 + i;
                        if (r > cc) { if (dirb == 0) Ap[tri_off(r) + cc] = c[i] * __expf(fminf(gFr[i] - gFc, 0.f)) * bFr[i];
                                      else Ap[tob + (63 - r)] = c[i] * __expf(fminf(gBc - gBr[3 - i], 0.f)) * bBc; } }
                }
            }
            int toA[4];
#pragma unroll
            for (int bi = 0; bi < 4; ++bi) toA[bi] = tri_off(16 * bi + n) + 4 * g4;
#define SA_LDA(bi, bk) (*(const LAS f32x4*)(Ap + toA[bi] + 16 * (bk)))
#define SA_STS(j, X) do { _Pragma("unroll") for (int e = 0; e < 4; ++e) Sb[256 * (j) + (4 * g4 + e) * 16 + n] = (X)[e]; } while (0)
#define SA_LDS(j) (*(const LAS f32x4*)(Sb + 256 * (j) + n * 16 + 4 * g4))
            f32x4 T[4][4];
            f32x4 Nop[4], Nr[4], X[4], P[4];
#pragma unroll
            for (int j = 0; j < 4; ++j) {
                const f32x4 raw = SA_LDA(j, j);
#pragma unroll
                for (int e = 0; e < 4; ++e) { Nop[j][e] = (4 * g4 + e < n) ? raw[e] : 0.f;
                    Nr[j][e] = (n < 4 * g4 + e) ? Ap[tri_off(16 * j + 4 * g4 + e) + 16 * j + n] : 0.f;
                    X[j][e] = ((n == 4 * g4 + e) ? 1.f : 0.f) - Nr[j][e]; }
                P[j] = mm4((f32x4){0.f, 0.f, 0.f, 0.f}, Nop[j], Nr[j]);
                SA_STS(j, P[j]);
            }
#pragma unroll
            for (int st = 0; st < 3; ++st)
#pragma unroll
                for (int j = 0; j < 4; ++j) {
                    const f32x4 pop = SA_LDS(j);
                    X[j] = mm4(X[j], pop, X[j]);
                    if (st < 2) { P[j] = mm4((f32x4){0.f, 0.f, 0.f, 0.f}, pop, P[j]); SA_STS(j, P[j]); }
                    else SA_STS(j, X[j]);
                }
#pragma unroll
            for (int j = 0; j < 4; ++j) T[j][j] = X[j];
#pragma unroll
            for (int d = 1; d < 4; ++d)
#pragma unroll
                for (int j = 0; j + d < 4; ++j) { const int bi = j + d;
                    f32x4 W = (f32x4){0.f, 0.f, 0.f, 0.f};
#pragma unroll
                    for (int k = j; k < bi; ++k) W = mm4(W, SA_LDA(bi, k), T[k][j]);
                    const f32x4 R = mm4((f32x4){0.f, 0.f, 0.f, 0.f}, SA_LDS(bi), W);
                    T[bi][j] = -R; }
#undef SA_LDA
#undef SA_STS
#undef SA_LDS
            asm volatile("" ::: "memory");
#pragma unroll
            for (int bi = 0; bi < 4; ++bi)
#pragma unroll
                for (int bj = 0; bj < 4; ++bj)
#pragma unroll
                    for (int e = 0; e < 4; ++e) stg[(16 * bi + 4 * g4 + e) * 72 + 16 * bj + n] = (bj <= bi) ? (unsigned short)f2bf(T[bi][bj][e]) : (unsigned short)0;
            const int item = dirb ? itemB : itemF;
#pragma unroll
            for (int it = 0; it < 6; ++it) { const int pc = it * 64 + lane, r = pc < 128 ? (pc >> 2) : 32 + ((pc - 128) >> 3), ch = pc < 128 ? (pc & 3) : ((pc - 128) & 7);
                const v4u v = *(const LAS v4u*)(wl + r * 144 + ch * 16); *(v4u*)(TQ + (size_t)item * TQ_ITEM + pc * 8) = v; }
            asm volatile("" ::: "memory");
        }
        {
            f32x4 pq[4][4];
#pragma unroll
            for (int half = 0; half < 2; ++half) {
                bf16x8 qf2[2][4];
#pragma unroll
                for (int b2 = 0; b2 < 2; ++b2) { const int row = row0 + 16 * (2 * half + b2) + n;
#pragma unroll
                    for (int s = 0; s < 4; ++s) qf2[b2][s] = *(const bf16x8*)(QN + (size_t)row * 3072 + h * HD + 32 * s + 8 * g4); }
#pragma unroll
                for (int b2 = 0; b2 < 2; ++b2)
#pragma unroll
                    for (int nb = 0; nb < 4; ++nb) { f32x4 c = (f32x4){0.f, 0.f, 0.f, 0.f};
#pragma unroll
                        for (int s = 0; s < 4; ++s) c = MFMA16(qf2[b2][s], kf[nb][s], c);
                        pq[2 * half + b2][nb] = c; }
                asm volatile("" ::: "memory");
            }
#pragma unroll
            for (int dirb = 0; dirb < 2; ++dirb) {
#pragma unroll
                for (int mb = 0; mb < 4; ++mb) {
                    const int rb0 = 16 * mb + 4 * g4;
                    const f32x4 gFr = *(const LAS f32x4*)(sgcF + rb0), gBr = *(const LAS f32x4*)(sgcB + 60 - rb0);
#pragma unroll
                    for (int nb = 0; nb < 4; ++nb) {
                        const int cc = 16 * nb + n; const float gFc = sgcF[cc], gBc = sgcB[63 - cc];
#pragma unroll
                        for (int i = 0; i < 4; ++i) { const int r = rb0 + i;
                            if (dirb == 0) stg[r * 72 + cc] = (unsigned short)f2bf((nb <= mb && r >= cc) ? pq[mb][nb][i] * __expf(fminf(gFr[i] - gFc, 0.f)) : 0.f);
                            else stg[(63 - r) * 72 + (63 - cc)] = (unsigned short)f2bf((nb >= mb && r <= cc) ? pq[mb][nb][i] * __expf(fminf(gBr[3 - i] - gBc, 0.f)) : 0.f); }
                    }
                }
                const int item = dirb ? itemB : itemF;
#pragma unroll
                for (int it = 0; it < 6; ++it) { const int pc = it * 64 + lane, r = pc < 128 ? (pc >> 2) : 32 + ((pc - 128) >> 3), ch = pc < 128 ? (pc & 3) : ((pc - 128) & 7);
                    const v4u v = *(const LAS v4u*)(wl + r * 144 + ch * 16); *(v4u*)(TQ + (size_t)(NITEM + item) * TQ_ITEM + pc * 8) = v; }
                asm volatile("" ::: "memory");
            }
        }
    }
}
DI bf16x8 ld2x8(const LAS unsigned char* p0, const LAS unsigned char* p1) { const v2u lo = *(const LAS v2u*)p0, hi = *(const LAS v2u*)p1; return __builtin_bit_cast(bf16x8, (v4u){lo.x, lo.y, hi.x, hi.y}); }
DI bf16x8 pack16(const f32x16& x, int s) { v4u p; p.x = cvtpk(x[8 * s], x[8 * s + 1]); p.y = cvtpk(x[8 * s + 2], x[8 * s + 3]); p.z = cvtpk(x[8 * s + 4], x[8 * s + 5]); p.w = cvtpk(x[8 * s + 6], x[8 * s + 7]); return __builtin_bit_cast(bf16x8, p); }
DI void st2x8(LAS unsigned char* p, const v4u v) { *(LAS v2u*)p = (v2u){v.x, v.y}; *(LAS v2u*)(p + 8) = (v2u){v.z, v.w}; }
DI void stperm(LAS unsigned char* rowp, int c, const v4u v) { LAS unsigned char* p = rowp + (16 * (c >> 1) + 4 * (c & 1)) * 2; *(LAS v2u*)p = (v2u){v.x, v.y}; *(LAS v2u*)(p + 16) = (v2u){v.z, v.w}; }
#define SBAR() do { asm volatile("s_waitcnt lgkmcnt(0)" ::: "memory"); __builtin_amdgcn_s_barrier(); asm volatile("" ::: "memory"); } while (0)
#define MULS(x, y) ((x) * (y))
template <int VAR> DI void ph_dn_scan2(CArgs& a, LAS unsigned char* lds, int g) {
    const int t = otid(), lane = t & 63, wave = __builtin_amdgcn_readfirstlane(t >> 6), r = lane & 31, h5 = lane >> 5, i16 = lane & 15, q4 = i16 >> 2, p4 = i16 & 3, blk = (lane >> 4) & 1;
    constexpr int KP = 272, TP = 144, OP = 80;
    constexpr int O_K = 0, O_Q = 64 * KP, O_V = 2 * 64 * KP, O_T = 3 * 64 * KP, O_QK = O_T + 64 * TP, O_SC = O_QK + 64 * TP, SETB = O_SC + 768;
    static_assert(2 * SETB + 4 * 64 * OP <= MISC_OFF, "scan LDS map");
    for (int chain = obid(); chain < 192; chain += gridDim.x) {
        const int seq = chain < 64 ? 8 + (chain >> 4) : (chain - 64) >> 4, h = (chain >> 1) & 7, dir = chain & 1;
        const int s0 = seq < 8 ? seq * 4096 : 32768 + (seq - 8) * 8192, L = seq < 8 ? 4096 : 8192, NC = L >> 6;
        if (wave >= 4) {
            int tL_ = t; asm volatile("" : "+v"(tL_)); const int tl = tL_ & 255;
            const bf16* QN = (const bf16*)(a.ws + WS_QKVN); const bf16* TQ = (const bf16*)(a.ws + ws_h(g)); const float* SC = (const float*)(a.ws + WS_SC);
            v4u rk[4], rq[4], rv[4], rt[2], rqk[2]; float rs = 0.f;
            int poff[4];
#pragma unroll
            for (int u = 0; u < 4; ++u) { const int idx = tl + 256 * u, ip = idx >> 4, ch = idx & 15; poff[u] = (dir ? 63 - ip : ip) * 3072 + ch * 8; }
#define DN_ISSUE(nn) do { const int r0_ = s0 + 64 * (dir ? NC - 1 - (nn) : (nn)); const size_t it_ = (size_t)(((r0_ >> 6) * 8 + h) * 2 + dir); \
            const bf16* qb_ = QN + (size_t)r0_ * 3072 + h * HD; const bf16* tb_ = TQ + it_ * TQ_ITEM; \
            _Pragma("unroll") for (int u = 0; u < 4; ++u) { rq[u] = *(const v4u*)(qb_ + poff[u]); rk[u] = *(const v4u*)(qb_ + 1024 + poff[u]); rv[u] = *(const v4u*)(qb_ + 2048 + poff[u]); } \
            _Pragma("unroll") for (int u = 0; u < 2; ++u) { const int pc = (u == 0 || tl < 128) ? tl + 256 * u : tl;     \
                rt[u] = *(const v4u*)(tb_ + pc * 8); rqk[u] = *(const v4u*)(tb_ + (size_t)NITEM * TQ_ITEM + pc * 8); } \
            if (tl < 192) rs = SC[it_ * 192 + tl]; } while (0)
#define DN_WRITE(set) do { LAS unsigned char* sb_ = lds + (set) * SETB; \
            _Pragma("unroll") for (int u = 0; u < 4; ++u) { const int idx = tl + 256 * u, ip = idx >> 4, ch = idx & 15; \
                stperm(sb_ + O_K + ip * KP, ch, rk[u]); stperm(sb_ + O_Q + ip * KP, ch, rq[u]); *(LAS v4u*)(sb_ + O_V + ip * KP + ch * 16) = rv[u]; } \
            _Pragma("unroll") for (int u = 0; u < 2; ++u) { if (u == 0 || tl < 128) { const int pc = tl + 256 * u, r_ = pc < 128 ? (pc >> 2) : 32 + ((pc - 128) >> 3), ch_ = pc < 128 ? (pc & 3) : ((pc - 128) & 7); \
                stperm(sb_ + O_T + r_ * TP, ch_, rt[u]); stperm(sb_ + O_QK + r_ * TP, ch_, rqk[u]); } } \
            if (tl < 192) ((LAS float*)(sb_ + O_SC))[tl] = rs; } while (0)
            if (VAR != 4) { DN_ISSUE(0); DN_WRITE(0); if (NC > 1) DN_ISSUE(1); }
            SBAR();
            for (int nn = 0; nn < NC; ++nn) {
                if (VAR != 4 && nn + 1 < NC) { DN_WRITE((nn + 1) & 1); if (nn + 2 < NC) DN_ISSUE(nn + 2); }
                SBAR();
            }
#undef DN_ISSUE
#undef DN_WRITE
        } else {
            int tc_ = t; asm volatile("" : "+v"(tc_));
            const int lane = tc_ & 63, r = lane & 31, h5 = lane >> 5, i16 = lane & 15, q4 = i16 >> 2, p4 = i16 & 3, blk = (lane >> 4) & 1;
            bf16* O = (bf16*)(a.ws + (VAR ? (dir ? WS_QKVD + 64 * MiB : WS_QKVD) : (dir ? WS_OB : WS_OF)));
            LAS unsigned char* Ow = lds + 2 * SETB + wave * (64 * OP);
            f32x16 S[4];
#pragma unroll
            for (int kb = 0; kb < 4; ++kb)
#pragma unroll
                for (int i = 0; i < 16; ++i) S[kb][i] = 0.f;
            SBAR();
            for (int nn = 0; nn < NC; ++nn) {
                const LAS unsigned char* sb = lds + (nn & 1) * SETB;
                const LAS unsigned char* Kc = sb + O_K; const LAS unsigned char* Qc = sb + O_Q; const LAS unsigned char* Vt = sb + O_V;
                const LAS unsigned char* Tc = sb + O_T; const LAS unsigned char* QKc = sb + O_QK; const LAS float* sc = (const LAS float*)(sb + O_SC);
                if (VAR != 2) {
                const float eglast = sc[63];
#define LDA(base, pitch, row, col16) (*(const LAS bf16x8*)((base) + (row) * (pitch) + ((col16) * 16 + 8 * h5) * 2))
                f32x16 P[2], Qs[2];
#pragma unroll
                for (int mb = 0; mb < 2; ++mb)
#pragma unroll
                    for (int i = 0; i < 16; ++i) { P[mb][i] = 0.f; Qs[mb][i] = 0.f; }
                bf16x8 fa[2][4];
#define LDG(dst, j_) do { dst[0] = LDA(Kc, KP, r, (j_)); dst[1] = LDA(Kc, KP, 32 + r, (j_)); dst[2] = LDA(Qc, KP, r, (j_)); dst[3] = LDA(Qc, KP, 32 + r, (j_)); } while (0)
                LDG(fa[0], 0);
                bf16x8 tf[6];
#pragma unroll
                for (int j = 0; j < 8; ++j) {
                    if (j + 1 < 8) LDG(fa[(j + 1) & 1], j + 1);
                    else { tf[0] = LDA(Tc, TP, r, 0); tf[1] = LDA(Tc, TP, r, 1); tf[2] = LDA(Tc, TP, 32 + r, 0); tf[3] = LDA(Tc, TP, 32 + r, 1); tf[4] = LDA(Tc, TP, 32 + r, 2); tf[5] = LDA(Tc, TP, 32 + r, 3); }
                    __builtin_amdgcn_sched_barrier(0);
                    const bf16x8 Bf = pack16(S[j >> 1], j & 1);
                    if (VAR != 3) { P[0] = MFMA32(fa[j & 1][0], Bf, P[0]); P[1] = MFMA32(fa[j & 1][1], Bf, P[1]); Qs[0] = MFMA32(Bf, fa[j & 1][2], Qs[0]); Qs[1] = MFMA32(Bf, fa[j & 1][3], Qs[1]); }
                    __builtin_amdgcn_sched_barrier(0);
                }
#undef LDG
#pragma unroll
                for (int mb = 0; mb < 2; ++mb)
#pragma unroll
                    for (int gi = 0; gi < 4; ++gi) {
                        const int tb = 32 * mb + 8 * gi + 4 * h5;
                        const s16x4 v4 = __builtin_amdgcn_ds_read_tr16_b64_v4i16((LAS s16x4*)(Vt + (tb + q4) * KP + (32 * wave + 16 * blk + 4 * p4) * 2));
                        const f32x4 egc4 = *(const LAS f32x4*)(sc + tb), bt4 = *(const LAS f32x4*)(sc + 64 + tb);
#pragma unroll
                        for (int ii = 0; ii < 4; ++ii) P[mb][4 * gi + ii] = MULS(bt4[ii], bf2f((unsigned)(unsigned short)v4[ii]) - MULS(egc4[ii], P[mb][4 * gi + ii]));
                    }
                bf16x8 qf6[6];
                qf6[0] = LDA(QKc, TP, r, 0); qf6[1] = LDA(QKc, TP, r, 1); qf6[2] = LDA(QKc, TP, 32 + r, 0); qf6[3] = LDA(QKc, TP, 32 + r, 1); qf6[4] = LDA(QKc, TP, 32 + r, 2); qf6[5] = LDA(QKc, TP, 32 + r, 3);
                __builtin_amdgcn_sched_barrier(0);
                f32x16 Vn[2];
#pragma unroll
                for (int mb = 0; mb < 2; ++mb)
#pragma unroll
                    for (int i = 0; i < 16; ++i) Vn[mb][i] = 0.f;
                { const bf16x8 R00 = pack16(P[0], 0), R01 = pack16(P[0], 1), R10 = pack16(P[1], 0), R11 = pack16(P[1], 1);
                  Vn[0] = MFMA32(tf[0], R00, Vn[0]); Vn[1] = MFMA32(tf[2], R00, Vn[1]); Vn[0] = MFMA32(tf[1], R01, Vn[0]); Vn[1] = MFMA32(tf[3], R01, Vn[1]); Vn[1] = MFMA32(tf[4], R10, Vn[1]); Vn[1] = MFMA32(tf[5], R11, Vn[1]); }
                s16x4 kt[2][8];
#define LDKT(dst, kb) do { _Pragma("unroll") for (int mj = 0; mj < 2; ++mj) _Pragma("unroll") for (int s = 0; s < 2; ++s) { \
                    dst[(mj * 2 + s) * 2] = __builtin_amdgcn_ds_read_tr16_b64_v4i16((LAS s16x4*)(Kc + (32 * mj + 16 * s + 4 * h5 + q4) * KP + (32 * (kb) + 16 * blk + pc4) * 2)); \
                    dst[(mj * 2 + s) * 2 + 1] = __builtin_amdgcn_ds_read_tr16_b64_v4i16((LAS s16x4*)(Kc + (32 * mj + 16 * s + 8 + 4 * h5 + q4) * KP + (32 * (kb) + 16 * blk + pc4) * 2)); } } while (0)
                const int pc4 = (p4 == 1 ? 8 : (p4 == 2 ? 4 : 4 * p4));
                if (VAR != 5) {
                { const bf16x8 V00 = pack16(Vn[0], 0), V01 = pack16(Vn[0], 1), V10 = pack16(Vn[1], 0), V11 = pack16(Vn[1], 1);
#pragma unroll
                  for (int mb = 0; mb < 2; ++mb) {
                    const float eg = sc[32 * mb + r];
                    f32x16 o = Qs[mb] * eg;
                    if (mb == 0) { o = MFMA32(V00, qf6[0], o); o = MFMA32(V01, qf6[1], o); }
                    else { o = MFMA32(V00, qf6[2], o); o = MFMA32(V01, qf6[3], o); o = MFMA32(V10, qf6[4], o); o = MFMA32(V11, qf6[5], o); }
#pragma unroll
                    for (int gi = 0; gi < 4; ++gi) { if (VAR != 8) *(LAS v2u*)(Ow + (32 * mb + r) * OP + (8 * gi + 4 * h5) * 2) = (v2u){cvtpk(o[4 * gi], o[4 * gi + 1]), cvtpk(o[4 * gi + 2], o[4 * gi + 3])}; else asm volatile("" :: "v"(o[4 * gi])); }
                  } }
                }
#pragma unroll
                for (int mb = 0; mb < 2; ++mb)
#pragma unroll
                    for (int gi = 0; gi < 4; ++gi) { const f32x4 ekd4 = *(const LAS f32x4*)(sc + 128 + 32 * mb + 8 * gi + 4 * h5);
#pragma unroll
                        for (int ii = 0; ii < 4; ++ii) Vn[mb][4 * gi + ii] = MULS(Vn[mb][4 * gi + ii], ekd4[ii]); }
                if (VAR != 6) LDKT(kt[0], 0);
                { const bf16x8 W[4] = {pack16(Vn[0], 0), pack16(Vn[0], 1), pack16(Vn[1], 0), pack16(Vn[1], 1)};
#pragma unroll
                  for (int kb = 0; kb < 4; ++kb) {
                    if (VAR != 6 && kb + 1 < 4) LDKT(kt[(kb + 1) & 1], kb + 1);
                    __builtin_amdgcn_sched_barrier(0);
#pragma unroll
                    for (int i = 0; i < 16; ++i) S[kb][i] = MULS(S[kb][i], eglast);
#pragma unroll
                    for (int q = 0; q < 4; ++q) if (VAR != 6) S[kb] = MFMA32(__builtin_shufflevector(kt[kb & 1][2 * q], kt[kb & 1][2 * q + 1], 0, 1, 2, 3, 4, 5, 6, 7), W[q], S[kb]);
                    __builtin_amdgcn_sched_barrier(0);
                  } }
#undef LDA
#undef LDKT
                if (VAR != 5 && VAR != 8) {
                { const int row0 = s0 + 64 * (dir ? NC - 1 - nn : nn);
#pragma unroll
                  for (int it = 0; it < 4; ++it) { const int idx = it * 64 + lane, ip = idx >> 2, ch = idx & 3;
                      const v4u ov_ = *(const LAS v4u*)(Ow + ip * OP + ch * 16); if (VAR != 7) *(v4u*)(O + (size_t)(row0 + (dir ? 63 - ip : ip)) * 1024 + h * HD + 32 * wave + ch * 8) = ov_; else asm volatile("" :: "v"(ov_)); } }
                }
                }
                SBAR();
            }
        }
    }
}
DI void ph_dn_merge(CArgs& a, int l) {
    const int lane = otid() & 63, wave = __builtin_amdgcn_readfirstlane(otid() >> 6), gw = obid() * NWAVES + wave, NGW = gridDim.x * NWAVES;
    const bf16* OF = (const bf16*)(a.ws + WS_OF); const bf16* OB = (const bf16*)(a.ws + WS_OB); const bf16* Z = (const bf16*)(a.ws + WS_Z); bf16* MIX = (bf16*)(a.ws + WS_MIX);
    const float* gain = a.in[9] + (size_t)l * HD + (lane & 7) * 16;
    float gn[16];
#pragma unroll
    for (int i = 0; i < 16; ++i) gn[i] = gain[i];
    for (int r = gw; r < TG; r += NGW) {
        float o[16], z[16]; float ss = 0.f;
#pragma unroll
        for (int hf = 0; hf < 2; ++hf) {
            const v4u f = *(const v4u*)(OF + (size_t)r * 1024 + lane * 16 + hf * 8), b = *(const v4u*)(OB + (size_t)r * 1024 + lane * 16 + hf * 8), zz = *(const v4u*)(Z + (size_t)r * 1024 + lane * 16 + hf * 8);
            const unsigned fw[4] = {f.x, f.y, f.z, f.w}, bw[4] = {b.x, b.y, b.z, b.w}, zw[4] = {zz.x, zz.y, zz.z, zz.w};
#pragma unroll
            for (int k = 0; k < 4; ++k) { o[hf * 8 + 2 * k] = bflo(fw[k]) + bflo(bw[k]); o[hf * 8 + 2 * k + 1] = bfhi(fw[k]) + bfhi(bw[k]); z[hf * 8 + 2 * k] = bflo(zw[k]); z[hf * 8 + 2 * k + 1] = bfhi(zw[k]); }
        }
#pragma unroll
        for (int i = 0; i < 16; ++i) ss += o[i] * o[i];
        ss += shx(ss, 1); ss += shx(ss, 2); ss += shx(ss, 4);
        const float rinv = rsqrtf(ss * (1.f / HD) + EPS);
        unsigned w[8];
#pragma unroll
        for (int k = 0; k < 8; ++k) w[k] = pk2(o[2 * k] * rinv * gn[2 * k] * siluf(z[2 * k]), o[2 * k + 1] * rinv * gn[2 * k + 1] * siluf(z[2 * k + 1]));
        *(v4u*)(MIX + (size_t)r * DM + 1024 + lane * 16) = (v4u){w[0], w[1], w[2], w[3]};
        *(v4u*)(MIX + (size_t)r * DM + 1024 + lane * 16 + 8) = (v4u){w[4], w[5], w[6], w[7]};
    }
}
DI void ph_ffn_fix(CArgs& a, int l) {
    const bf16* ED = (const bf16*)(a.ws + WS_EDGE); bf16* GA = (bf16*)(a.ws + WS_GACT);
    const float* cw = a.in[14] + (size_t)l * 3 * NUP; const float* cb = a.in[15] + (size_t)l * NUP;
    constexpr int NCG = DFF / 8, NBLK = TG / 64;
    for (int task = obid() * NTHR + otid(); task < NBLK * NCG * 2; task += gridDim.x * NTHR) {
        const int which = task & 1, t2 = task >> 1, blk = t2 / NCG, c0 = (t2 % NCG) * 8, row0 = blk * 64;
        int s0, L; seq_of(row0, s0, L);
        const v4u zz = (v4u){0u, 0u, 0u, 0u};
        const bf16* e = ED + (size_t)blk * 4 * NUP + c0;
        v4u pg, pu, cg, cu, ng, nu; int row;
        if (which == 0) { row = row0; const bool hp = row0 > s0;
            pg = hp ? *(const v4u*)(e - NUP) : zz; pu = hp ? *(const v4u*)(e - NUP + DFF) : zz;
            cg = *(const v4u*)e; cu = *(const v4u*)(e + DFF); ng = *(const v4u*)(e + NUP); nu = *(const v4u*)(e + NUP + DFF); }
        else { row = row0 + 63; const bool hn = row0 + 64 < s0 + L;
            pg = *(const v4u*)(e + 2 * NUP); pu = *(const v4u*)(e + 2 * NUP + DFF); cg = *(const v4u*)(e + 3 * NUP); cu = *(const v4u*)(e + 3 * NUP + DFF);
            ng = hn ? *(const v4u*)(e + 4 * NUP) : zz; nu = hn ? *(const v4u*)(e + 4 * NUP + DFF) : zz; }
        const unsigned a0[4] = {pg.x, pg.y, pg.z, pg.w}, a1[4] = {cg.x, cg.y, cg.z, cg.w}, a2[4] = {ng.x, ng.y, ng.z, ng.w};
        const unsigned b0[4] = {pu.x, pu.y, pu.z, pu.w}, b1[4] = {cu.x, cu.y, cu.z, cu.w}, b2[4] = {nu.x, nu.y, nu.z, nu.w};
        unsigned w[4];
#pragma unroll
        for (int k = 0; k < 4; ++k) {
            const int c = c0 + 2 * k;
            const float g0 = cw[c] * bflo(a0[k]) + cw[NUP + c] * bflo(a1[k]) + cw[2 * NUP + c] * bflo(a2[k]) + cb[c];
            const float g1 = cw[c + 1] * bfhi(a0[k]) + cw[NUP + c + 1] * bfhi(a1[k]) + cw[2 * NUP + c + 1] * bfhi(a2[k]) + cb[c + 1];
            const float u0 = cw[DFF + c] * bflo(b0[k]) + cw[NUP + DFF + c] * bflo(b1[k]) + cw[2 * NUP + DFF + c] * bflo(b2[k]) + cb[DFF + c];
            const float u1 = cw[DFF + c + 1] * bfhi(b0[k]) + cw[NUP + DFF + c + 1] * bfhi(b1[k]) + cw[2 * NUP + DFF + c + 1] * bfhi(b2[k]) + cb[DFF + c + 1];
            w[k] = cvtpk(siluf(g0) * u0, siluf(g1) * u1);
        }
        *(v4u*)(GA + (size_t)row * DFF + c0) = (v4u){w[0], w[1], w[2], w[3]};
    }
}
#ifndef SCANVAR
#define SCANVAR 0
#endif
#ifndef WGM_IN
#define WGM_IN 4
#endif
#ifndef WGM_OUT
#define WGM_OUT 4
#endif
#ifndef WGM_UP
#define WGM_UP 4
#endif
#ifndef WGM_DN
#define WGM_DN 4
#endif
#ifndef PROBE
#define PROBE 0
#endif
#ifndef ATTVAR
#define ATTVAR 0
#endif
#ifndef DBG_X
#define DBG_X WS_QKVD
#endif
#ifndef DBG_H
#define DBG_H WS_OF
#endif
constexpr int NSTEPS = 1 + DEPTH * (1 + NGRP * 9) + NGRP + ((PROBE & 64) ? DEPTH * NGRP : 0);
__global__ void __launch_bounds__(NTHR, 2) fwd(Args a_unused) {
    extern __shared__ __attribute__((aligned(16))) unsigned char lds_raw[];
    LAS unsigned char* lds = (LAS unsigned char*)lds_raw;
    const int tid = threadIdx.x;
    CArgs* ap0 = (CArgs*)__builtin_amdgcn_kernarg_segment_ptr();
#define a (*({ CArgs* p_ = ap0; asm volatile("" : "+s"(p_)); p_; }))
    volatile LAS unsigned* MISC = (volatile LAS unsigned*)(lds + MISC_OFF);
    for (int u = tid; u < (LDS_BYTES - MISC_OFF) / 4; u += NTHR) ((LAS unsigned*)(lds + MISC_OFF))[u] = 0u;
    __syncthreads();
    unsigned* ctl = (unsigned*)(a.ws + WS_CTL);
    const bool single = (a.s_hi - a.s_lo) > 1;
    XcdBarrier bar; bar.bar = ctl + CW_BAR; bar.x = 0; bar.st = nullptr;
    if (single) bar = xcd_barrier_post(ctl + CW_BAR, MISC + 8);
    int step = 0, L0 = 0, G0 = 0, HF0 = 0;
#define REP(bit) for (int rep_ = 0; rep_ < (((PROBE) >> (bit)) & 1) + 1; ++rep_)
#define RUN(...) do { if (step >= a.s_lo && step < a.s_hi) { int l = L0, g = G0, half = HF0; asm volatile("" : "+s"(l), "+s"(g), "+s"(half)); (void)l; (void)g; (void)half; __builtin_amdgcn_s_waitcnt(0);   __VA_ARGS__; if (step + 1 < a.s_hi) { XcdBarrier b2_ = bar; asm volatile("" : "+s"(b2_.bar), "+s"(b2_.x)); xcd_barrier(b2_); } } ++step; } while (0)
    RUN(ph_bias(a.in[2], (float*)(a.ws + WS_BIAS)));
    for (L0 = 0; L0 < DEPTH; ++L0) {
        RUN(REP(5) ph_weights(a, l, lds));
        for (G0 = 0; G0 < NGRP; ++G0) {
            if (L0 == 0) RUN(REP(4) ph_prenorm(a, l, g));
            RUN(REP(0) { pg8::Gemm gm{(const bf16*)(a.ws + ws_h(g)), (const bf16*)(a.ws + WS_WIN), TG, INP, DM}; pg8::StaticOrder S; S.init(TG, INP, (int)gridDim.x, (int)blockIdx.x, WGM_IN);
                  pg8::EpiRoute E{(bf16*)(a.ws + WS_QKVA), (bf16*)(a.ws + WS_QKVD), (bf16*)(a.ws + WS_Z), (float*)(a.ws + WS_GATES), 3072, 3072, 1024, 12, 24, 28};
                  pg8::gemm_phase<pg8::EpiRoute, pg8::StaticOrder, true, true>(lds, gm, S, E); });
            RUN(REP(1) ph_dn_prep(a, l));
            RUN(REP(2) ph_dn_stageA(a, lds, g));
            RUN(REP(3) { if (rep_ == 0) ph_dn_scan2<0>(a, lds, g); else if (SCANVAR >= 0) ph_dn_scan2<(SCANVAR >= 0 ? SCANVAR : 0)>(a, lds, g); ph_attn2<0>(a, lds, l, g, rep_); });
#if (PROBE & 64)
            RUN(ph_attn2<ATTVAR>(a, lds, l, g, 1));
#endif
            RUN(REP(4) { ph_attn_merge(a, l); ph_dn_merge(a, l); });
            RUN(REP(0) { pg8::Gemm gm{(const bf16*)(a.ws + WS_MIX), (const bf16*)(a.ws + WS_WOUT), TG, DM, DM}; pg8::StaticOrder S; S.init(TG, DM, (int)gridDim.x, (int)blockIdx.x, WGM_OUT);
                  pg8::EpiPM E{(const unsigned long long __attribute__((address_space(4)))*)&a, 11, 12, l * DM, l * DM, (unsigned)WS_H, (unsigned)WS_XCH, (unsigned)(WS_CTL + 4 * (CW_XCH + (l * 2 + 0) * 512)),
                                (LAS float*)(lds + RING_BYTES), TG / 256, 0, 0u, 0u, 0u};
                  pg8::gemm_phase<pg8::EpiPM, pg8::StaticOrder, true, true>(lds, gm, S, E); });
            RUN(REP(0) { pg8::Gemm gm{(const bf16*)(a.ws + ws_h(g)), (const bf16*)(a.ws + WS_WUP), TG, NUP, DM}; pg8::StaticOrder S; S.init(TG, NUP, (int)gridDim.x, (int)blockIdx.x, WGM_UP);
                  pg8::EpiGate E{(bf16*)(a.ws + WS_GACT), (bf16*)(a.ws + WS_EDGE), a.in[14] + (size_t)l * 3 * NUP, a.in[15] + (size_t)l * NUP};
                  pg8::gemm_phase<pg8::EpiGate, pg8::StaticOrder, true, true>(lds, gm, S, E); });
            RUN(REP(7) ph_ffn_fix(a, l));
            RUN(REP(0) { pg8::Gemm gm{(const bf16*)(a.ws + WS_GACT), (const bf16*)(a.ws + WS_WDN), TG, DM, DFF}; pg8::StaticOrder S; S.init(TG, DM, (int)gridDim.x, (int)blockIdx.x, WGM_DN);
                  pg8::EpiPM E{(const unsigned long long __attribute__((address_space(4)))*)&a, 17, 3, l * DM, (l + 1 < DEPTH ? l + 1 : l) * DM, (unsigned)WS_H, (unsigned)WS_XCH, (unsigned)(WS_CTL + 4 * (CW_XCH + (l * 2 + 1) * 512)),
                                (LAS float*)(lds + RING_BYTES), TG / 256, l == DEPTH - 1, 0u, 0u, 0u};
                  pg8::gemm_phase<pg8::EpiPM, pg8::StaticOrder, true, true>(lds, gm, S, E); });
        }
    }
#undef RUN
#undef a
}

#ifndef ONE_LAUNCH
#define ONE_LAUNCH 1
#endif
extern "C" void kernel_launch(void* const* d_in, const int* in_sizes, int n_in, void* d_out, int out_size, void* d_ws, size_t ws_size, hipStream_t stream) {
    static int grid = 0;
    if (grid == 0) {
        if (n_in != 18 || ws_size < WS_END || out_size != 2 * 32768 * DM) { fprintf(stderr, "kernel_launch: unexpected shapes (n_in %d, out %d, ws %zu; need ws >= %zu)\n", n_in, out_size, ws_size, (size_t)WS_END); grid = -1; return; }
        int dev = 0, cus = 0;
        if (hipGetDevice(&dev) != hipSuccess || hipDeviceGetAttribute(&cus, hipDeviceAttributeMultiprocessorCount, dev) != hipSuccess) { grid = -1; return; }
        if (hipFuncSetAttribute((const void*)fwd, hipFuncAttributeMaxDynamicSharedMemorySize, LDS_BYTES) != hipSuccess) { fprintf(stderr, "kernel_launch: hipFuncSetAttribute failed\n"); grid = -1; return; }
        int per_cu = 0;
        if (hipOccupancyMaxActiveBlocksPerMultiprocessor(&per_cu, (const void*)fwd, NTHR, LDS_BYTES) != hipSuccess || per_cu < 1) { fprintf(stderr, "kernel_launch: occupancy query says %d\n", per_cu); }
        (void)hipGetLastError();
        grid = cus;
    }
    if (grid < 0) return;
    (void)hipMemsetAsync((char*)d_ws + WS_CTL, 0, CTL_ZERO_BYTES, stream);
    Args a{};
    for (int i = 0; i < 18; ++i) a.in[i] = (const float*)d_in[i];
    a.out = (float*)d_out; a.ws = (unsigned char*)d_ws;
    if (ONE_LAUNCH) { a.s_lo = 0; a.s_hi = NSTEPS; hipLaunchKernelGGL(fwd, dim3(grid), dim3(NTHR), LDS_BYTES, stream, a); }
    else for (int s = 0; s < NSTEPS; ++s) { a.s_lo = s; a.s_hi = s + 1; hipLaunchKernelGGL(fwd, dim3(grid), dim3(NTHR), LDS_BYTES, stream, a); }
}
```

```cpp
#include <hip/hip_runtime.h>
#include <cstdio>
#include <cstdint>
namespace pg8 {
#define PG8_LAS __attribute__((address_space(3)))
typedef unsigned short bf16_t;
typedef short bf16x8 __attribute__((ext_vector_type(8)));
typedef float f32x4 __attribute__((ext_vector_type(4)));
typedef unsigned u32x4 __attribute__((ext_vector_type(4)));
constexpr int BM = 256, BK = 64, HALF = 128, HTB = HALF * BK * 2  , STAGE_BYTES = 8 * HTB, NXCD = 8, WGM = 4;

__host__ __device__ __forceinline__ int lds_byte(int r, int c) { const int st = (r >> 4) * 2 + (c >> 5), rr = r & 15, cc = c & 31, ob = rr * 64 + cc * 2; return st * 1024 + (ob ^ (((ob >> 9) & 1) << 5)); }
__host__ __device__ __forceinline__ void stage_rc(int b, int& R, int& C) { const int st = b / 1024, sb = b % 1024, swz = sb ^ (((sb >> 9) & 1) << 5); R = (st >> 1) * 16 + swz / 64; C = (st & 1) * 32 + (swz % 64) / 2; }
__host__ __device__ __forceinline__ int perm32(int rho) { const int n = rho >> 4, i = rho & 15; return 8 * (i >> 2) + 4 * n + (i & 3); }

struct Unit { int pm, pn; };
struct Gemm { const bf16_t* A; const bf16_t* Bt; int M, N, K; };

struct StaticOrder {
    int nM, nN, nwg, G, c, wgm;
    __host__ __device__ void init(int M, int N, int G_, int c_, int wgm_ = WGM) { nM = M / BM; nN = N / BM; nwg = nM * nN; G = G_; c = c_; wgm = wgm_; }
    __host__ __device__ bool next(int i, Unit& u) const {
        const long L = (long)i * G + c; if (L >= nwg) return false;
        int wgid = (int)L; { const int q = nwg / NXCD, r = nwg % NXCD, xcd = wgid % NXCD, off = wgid / NXCD; wgid = (xcd < r ? xcd * (q + 1) : r * (q + 1) + (xcd - r) * q) + off; }
        const int nig = wgm * nN, gid = wgid / nig, fm = gid * wgm, gsz = (nM - fm) < wgm ? (nM - fm) : wgm;
        u.pm = fm + ((wgid % nig) % gsz); u.pn = (wgid % nig) / gsz; return true;
    }
    __device__ __forceinline__ void a_ready(const Unit&) const {}
    __device__ __forceinline__ void done(const Unit&) const {}
};
__device__ __forceinline__ unsigned cvt_pk_bf16(float lo, float hi) { unsigned r; asm volatile("v_cvt_pk_bf16_f32 %0, %1, %2" : "=v"(r) : "v"(lo), "v"(hi)); return r; }
struct EpiRoute {
    static constexpr bool PERM = true, AFTER_DRAIN = false;
    bf16_t* d0; bf16_t* d1; bf16_t* d2; float* gates;
    int ld0, ld1, ld2, t1, t2, t3;
    __device__ __forceinline__ void operator()(const f32x4 (&acc)[2][2][4][2], const Unit& u, int wr, int wc, int fr, int fq) const {
        const int row0 = u.pm * BM + wr * 64 + fr;
        if (u.pn >= t3) {
            if (wc == 0) {
#pragma unroll
                for (int ai = 0; ai < 2; ++ai)
#pragma unroll
                    for (int m = 0; m < 4; ++m) { float* rowp = gates + (size_t)(row0 + ai * HALF + m * 16) * 32 + 8 * fq;
                        *(f32x4*)(rowp) = acc[ai][0][m][0]; *(f32x4*)(rowp + 4) = acc[ai][0][m][1]; }
            }
            return;
        }
        bf16_t* base; int ldc, colt;
        if (u.pn < t1) { base = d0; ldc = ld0; colt = u.pn * BM; }
        else if (u.pn < t2) { base = d1; ldc = ld1; colt = (u.pn - t1) * BM; }
        else { base = d2; ldc = ld2; colt = (u.pn - t2) * BM; }
        const int col0 = colt + wc * 32 + 8 * fq;
#pragma unroll
        for (int ai = 0; ai < 2; ++ai)
#pragma unroll
            for (int m = 0; m < 4; ++m) { bf16_t* rowp = base + (size_t)(row0 + ai * HALF + m * 16) * ldc + col0;
#pragma unroll
                for (int bj = 0; bj < 2; ++bj) { const f32x4 v0 = acc[ai][bj][m][0], v1 = acc[ai][bj][m][1];
                    u32x4 w; w.x = cvt_pk_bf16(v0[0], v0[1]); w.y = cvt_pk_bf16(v0[2], v0[3]); w.z = cvt_pk_bf16(v1[0], v1[1]); w.w = cvt_pk_bf16(v1[2], v1[3]);
                    *(u32x4*)(rowp + bj * HALF) = w; } }
    }
};

constexpr int E_DFF = 5632, E_NUP = 11264;
__device__ __forceinline__ float dpp_ror1(float x) { return __builtin_bit_cast(float, __builtin_amdgcn_mov_dpp(__builtin_bit_cast(int, x), 0x121, 0xf, 0xf, true)); }
__device__ __forceinline__ float dpp_rol1(float x) { return __builtin_bit_cast(float, __builtin_amdgcn_mov_dpp(__builtin_bit_cast(int, x), 0x12F, 0xf, 0xf, true)); }
typedef unsigned u32x2 __attribute__((ext_vector_type(2)));
struct EpiGate {
    static constexpr bool PERM = true, AFTER_DRAIN = false;
    bf16_t* GA; bf16_t* EDGE; const float* cw; const float* cb;
    __device__ __forceinline__ void operator()(const f32x4 (&acc)[2][2][4][2], const Unit& u, int wr, int wc, int fr, int fq) const {
        const int rowb = u.pm * BM + wr * 64;
        f32x4 WT[2][8];
#pragma unroll
        for (int n = 0; n < 2; ++n) {
            const int ch0 = u.pn * 128 + wc * 32 + fq * 8 + n * 4;
            WT[n][0] = *(const f32x4*)(cw + ch0); WT[n][1] = *(const f32x4*)(cw + E_NUP + ch0); WT[n][2] = *(const f32x4*)(cw + 2 * E_NUP + ch0);
            WT[n][3] = *(const f32x4*)(cw + E_DFF + ch0); WT[n][4] = *(const f32x4*)(cw + E_NUP + E_DFF + ch0); WT[n][5] = *(const f32x4*)(cw + 2 * E_NUP + E_DFF + ch0);
            WT[n][6] = *(const f32x4*)(cb + ch0); WT[n][7] = *(const f32x4*)(cb + E_DFF + ch0);
        }
#pragma unroll
        for (int n = 0; n < 2; ++n) {
            const int ch0 = u.pn * 128 + wc * 32 + fq * 8 + n * 4;
            const f32x4 wg0 = WT[n][0], wg1 = WT[n][1], wg2 = WT[n][2], wu0 = WT[n][3], wu1 = WT[n][4], wu2 = WT[n][5], bg = WT[n][6], bu = WT[n][7];
#pragma unroll
            for (int ai = 0; ai < 2; ++ai) {
                const int blk = (rowb + ai * HALF) >> 6;
#pragma unroll
                for (int m = 0; m < 4; ++m) {
                    const f32x4 cg = acc[ai][0][m][n], cu = acc[ai][1][m][n];
                    float o[4];
#pragma unroll
                    for (int i = 0; i < 4; ++i) {
                        const float sgp = (m > 0 && fr == 15) ? acc[ai][0][m > 0 ? m - 1 : 0][n][i] : cg[i], sup = (m > 0 && fr == 15) ? acc[ai][1][m > 0 ? m - 1 : 0][n][i] : cu[i];
                        const float sgn = (m < 3 && fr == 0) ? acc[ai][0][m < 3 ? m + 1 : 3][n][i] : cg[i], sun = (m < 3 && fr == 0) ? acc[ai][1][m < 3 ? m + 1 : 3][n][i] : cu[i];
                        const float pg = dpp_ror1(sgp), pu = dpp_ror1(sup), ng = dpp_rol1(sgn), nu = dpp_rol1(sun);
                        const float g = wg0[i] * pg + wg1[i] * cg[i] + wg2[i] * ng + bg[i];
                        const float uu = wu0[i] * pu + wu1[i] * cu[i] + wu2[i] * nu + bu[i];
                        o[i] = g * __builtin_amdgcn_rcpf(1.f + __expf(-g)) * uu;
                    }
                    const bool edge = (m == 0 && fr == 0) || (m == 3 && fr == 15);
                    if (!edge) { u32x2 w; w.x = cvt_pk_bf16(o[0], o[1]); w.y = cvt_pk_bf16(o[2], o[3]); *(u32x2*)(GA + (size_t)(rowb + ai * HALF + m * 16 + fr) * E_DFF + ch0) = w; }
                    if (m == 0 && fr < 2) { bf16_t* ep = EDGE + ((size_t)blk * 4 + fr) * E_NUP + ch0;
                        u32x2 w; w.x = cvt_pk_bf16(cg[0], cg[1]); w.y = cvt_pk_bf16(cg[2], cg[3]); *(u32x2*)ep = w; w.x = cvt_pk_bf16(cu[0], cu[1]); w.y = cvt_pk_bf16(cu[2], cu[3]); *(u32x2*)(ep + E_DFF) = w; }
                    if (m == 3 && fr >= 14) { bf16_t* ep = EDGE + ((size_t)blk * 4 + 2 + (fr - 14)) * E_NUP + ch0;
                        u32x2 w; w.x = cvt_pk_bf16(cg[0], cg[1]); w.y = cvt_pk_bf16(cg[2], cg[3]); *(u32x2*)ep = w; w.x = cvt_pk_bf16(cu[0], cu[1]); w.y = cvt_pk_bf16(cu[2], cu[3]); *(u32x2*)(ep + E_DFF) = w; }
                }
            }
        }
    }
};

__device__ __forceinline__ float xch_sum4(float x) {
    float a = x, b = x;
    asm volatile("s_nop 1\n\tv_permlane16_swap_b32 %0, %1\n\ts_nop 1" : "+v"(a), "+v"(b));
    x = a + b; a = x; b = x;
    asm volatile("s_nop 1\n\tv_permlane32_swap_b32 %0, %1\n\ts_nop 1" : "+v"(a), "+v"(b));
    return a + b; }
struct EpiPM {
    static constexpr bool PERM = true, AFTER_DRAIN = false;
    const unsigned long long __attribute__((address_space(4)))* ka;
    int gi1, gi2, goff1, goff2;
    unsigned h_off, xch_off;
    unsigned tag0;
    PG8_LAS float* sc;
    int npan, last;
    __device__ __forceinline__ void exchange(int which, const float (&p)[2][4], float (&r)[2][4], const Unit& u, int t, int wr, int wc, int fr, int fq) const {
#pragma unroll
        for (int ai = 0; ai < 2; ++ai)
#pragma unroll
            for (int m = 0; m < 4; ++m) { const float v = xch_sum4(p[ai][m]); if (fq == 0) sc[wc * 256 + ai * HALF + wr * 64 + m * 16 + fr] = v; }
        asm volatile("s_waitcnt lgkmcnt(0)" ::: "memory"); __builtin_amdgcn_s_barrier(); asm volatile("" ::: "memory");
        typedef __attribute__((address_space(1))) unsigned long long gu64;
        unsigned char* ws_ = (unsigned char*)ka[19];
        gu64* sl = (gu64*)(unsigned long long*)(ws_ + xch_off) + ((size_t)which * npan + u.pm) * 2048;
        const unsigned long long tag = (unsigned long long)(unsigned)(tag0 + which) << 32;
        if (t < 256) { const float part = (sc[t] + sc[256 + t]) + (sc[512 + t] + sc[768 + t]);
            __hip_atomic_store(sl + u.pn * 256 + t, tag | __builtin_bit_cast(unsigned, part), __ATOMIC_RELAXED, __HIP_MEMORY_SCOPE_AGENT);
            float tot;
            for (;;) { unsigned long long w[8]; bool ok = true;
#pragma unroll
                for (int q = 0; q < 8; ++q) w[q] = __hip_atomic_load(sl + q * 256 + t, __ATOMIC_RELAXED, __HIP_MEMORY_SCOPE_AGENT);
                tot = 0.f;
#pragma unroll
                for (int q = 0; q < 8; ++q) { ok = ok && ((w[q] >> 32) == (tag >> 32)); tot += __builtin_bit_cast(float, (unsigned)w[q]); }
                if (ok) break;
                __builtin_amdgcn_s_sleep(1); }
            sc[1024 + t] = __builtin_amdgcn_rsqf(tot * (1.f / 2048.f) + 1e-6f); }
        asm volatile("s_waitcnt vmcnt(0) lgkmcnt(0)" ::: "memory"); __builtin_amdgcn_s_barrier(); asm volatile("" ::: "memory");
#pragma unroll
        for (int ai = 0; ai < 2; ++ai)
#pragma unroll
            for (int m = 0; m < 4; ++m) r[ai][m] = sc[1024 + ai * HALF + wr * 64 + m * 16 + fr];
        asm volatile("s_waitcnt lgkmcnt(0)" ::: "memory"); __builtin_amdgcn_s_barrier(); asm volatile("" ::: "memory");
    }
    __device__ __forceinline__ void operator()(const f32x4 (&acc_)[2][2][4][2], const Unit& u, int wr, int wc, int fr_, int fq_) const {
        f32x4 (&acc)[2][2][4][2] = const_cast<f32x4 (&)[2][2][4][2]>(acc_);
        (void)fr_; (void)fq_;
#define EPM_LANE() int lane_ = (int)__builtin_amdgcn_mbcnt_hi(~0u, __builtin_amdgcn_mbcnt_lo(~0u, 0u)); asm volatile("" : "+v"(lane_)); const int fr = lane_ & 15, fq = lane_ >> 4; \
        const int t = (wr * 4 + wc) * 64 + fq * 16 + fr; const int col0 = u.pn * BM + wc * 32 + 8 * fq; (void)t; (void)col0
        float* xrow = (float*)ka[18];
        float p[2][4], rinv[2][4];
        { EPM_LANE();
#pragma unroll
        for (int ai = 0; ai < 2; ++ai)
#pragma unroll
            for (int m = 0; m < 4; ++m) { float s = 0.f;
#pragma unroll
                for (int bj = 0; bj < 2; ++bj)
#pragma unroll
                    for (int n = 0; n < 2; ++n) { const f32x4 v = acc[ai][bj][m][n]; s += (v[0] * v[0] + v[1] * v[1]) + (v[2] * v[2] + v[3] * v[3]); }
                p[ai][m] = s; }
        exchange(0, p, rinv, u, t, wr, wc, fr, fq); }
        { EPM_LANE(); f32x4 G[2][2];
          const float* g1 = (const float*)ka[gi1] + goff1;
#pragma unroll
          for (int bj = 0; bj < 2; ++bj) { G[bj][0] = *(const f32x4*)(g1 + col0 + bj * HALF); G[bj][1] = *(const f32x4*)(g1 + col0 + bj * HALF + 4); }
#pragma unroll
          for (int ai = 0; ai < 2; ++ai) {
            u32x4 xw4[4][2];
#pragma unroll
            for (int m = 0; m < 4; ++m) { const size_t R = (size_t)u.pm * BM + ai * HALF + wr * 64 + m * 16 + fr; const bf16_t* xr = (const bf16_t*)(xrow + R * 2048);
#pragma unroll
                for (int bj = 0; bj < 2; ++bj) xw4[m][bj] = *(const u32x4*)(xr + col0 + bj * HALF); }
#pragma unroll
            for (int m = 0; m < 4; ++m) {
                float s = 0.f; const float ri = rinv[ai][m];
#pragma unroll
                for (int bj = 0; bj < 2; ++bj) { const unsigned w[4] = {xw4[m][bj].x, xw4[m][bj].y, xw4[m][bj].z, xw4[m][bj].w};
#pragma unroll
                    for (int n = 0; n < 2; ++n) { f32x4 v = acc[ai][bj][m][n]; const f32x4 gg = G[bj][n];
                        v[0] = __builtin_bit_cast(float, w[2 * n] << 16) + v[0] * ri * gg[0]; v[1] = __builtin_bit_cast(float, w[2 * n] & 0xffff0000u) + v[1] * ri * gg[1];
                        v[2] = __builtin_bit_cast(float, w[2 * n + 1] << 16) + v[2] * ri * gg[2]; v[3] = __builtin_bit_cast(float, w[2 * n + 1] & 0xffff0000u) + v[3] * ri * gg[3];
                        acc[ai][bj][m][n] = v; s += (v[0] * v[0] + v[1] * v[1]) + (v[2] * v[2] + v[3] * v[3]); } }
                p[ai][m] = s; }
            asm volatile("" ::: "memory"); }
        exchange(1, p, rinv, u, t, wr, wc, fr, fq); }
        EPM_LANE();
        if (last) {
#pragma unroll
            for (int ai = 0; ai < 2; ++ai)
#pragma unroll
                for (int m = 0; m < 4; ++m) { const size_t R = (size_t)u.pm * BM + ai * HALF + wr * 64 + m * 16 + fr; float* xo = xrow + R * 2048 + col0;
#pragma unroll
                    for (int bj = 0; bj < 2; ++bj) { *(f32x4*)(xo + bj * HALF) = acc[ai][bj][m][0]; *(f32x4*)(xo + bj * HALF + 4) = acc[ai][bj][m][1]; } }
        } else {
            f32x4 G[2][2]; const float* g2 = (const float*)ka[gi2] + goff2;
#pragma unroll
            for (int bj = 0; bj < 2; ++bj) { G[bj][0] = *(const f32x4*)(g2 + col0 + bj * HALF); G[bj][1] = *(const f32x4*)(g2 + col0 + bj * HALF + 4); }
            bf16_t* H = (bf16_t*)((unsigned char*)ka[19] + h_off);
#pragma unroll
            for (int ai = 0; ai < 2; ++ai)
#pragma unroll
                for (int m = 0; m < 4; ++m) { const size_t R = (size_t)u.pm * BM + ai * HALF + wr * 64 + m * 16 + fr; bf16_t* xo = (bf16_t*)(xrow + R * 2048) + col0; bf16_t* ho = H + R * 2048 + col0;
                    const float s2 = rinv[ai][m];
#pragma unroll
                    for (int bj = 0; bj < 2; ++bj) { const f32x4 v0 = acc[ai][bj][m][0], v1 = acc[ai][bj][m][1]; const f32x4 a0 = G[bj][0], a1 = G[bj][1];
                        u32x4 w; w.x = cvt_pk_bf16(v0[0], v0[1]); w.y = cvt_pk_bf16(v0[2], v0[3]); w.z = cvt_pk_bf16(v1[0], v1[1]); w.w = cvt_pk_bf16(v1[2], v1[3]);
                        *(u32x4*)(xo + bj * HALF) = w;
                        w.x = cvt_pk_bf16(v0[0] * s2 * a0[0], v0[1] * s2 * a0[1]); w.y = cvt_pk_bf16(v0[2] * s2 * a0[2], v0[3] * s2 * a0[3]);
                        w.z = cvt_pk_bf16(v1[0] * s2 * a1[0], v1[1] * s2 * a1[1]); w.w = cvt_pk_bf16(v1[2] * s2 * a1[2], v1[3] * s2 * a1[3]);
                        *(u32x4*)(ho + bj * HALF) = w; } }
        }
#undef EPM_LANE
    }
};
template <class Epi, class Sched, bool ALIGN_EPI = false, bool SP2 = false>
__device__ __forceinline__ void gemm_phase(PG8_LAS unsigned char* lds, const Gemm g, const Sched& S, const Epi& E) {
    int tid_ = threadIdx.x; asm volatile("" : "+v"(tid_));
    const int tid = tid_, wid = __builtin_amdgcn_readfirstlane(tid >> 6), lane = tid & 63, wr = wid >> 2, wc = wid & 3, fr = lane & 15, fq = lane >> 4;
    const int K = g.K, nt = K / BK;
    unsigned voffA[2], voffB[2];
#pragma unroll
    for (int i = 0; i < 2; ++i) { int R, C; stage_rc(tid * 16 + i * 8192, R, C); const int Rb = Epi::PERM ? ((R & ~31) + perm32(R & 31)) : R;
        voffA[i] = (unsigned)(R * K + C) * 2u; voffB[i] = (unsigned)(Rb * K + C) * 2u; }
    const size_t kstep = (size_t)(BK * 2);
    const size_t hstep = (size_t)HALF * K * 2;
    const size_t tstep = 2 * hstep;
    const unsigned ldsw = (unsigned)wid * 1024u;
    const int aoff = lds_byte(wr * 64 + fr, fq * 8), boff = lds_byte(wc * 32 + fr, fq * 8);
#define PG8_SA(b, h) (((b) * 2 + (h)) * HTB)
#define PG8_SB(b, h) ((4 + (b) * 2 + (h)) * HTB)
#define PG8_STAGE(bufoff, gbase, voff) do { _Pragma("unroll") for (int _i = 0; _i < 2; ++_i) \
        __builtin_amdgcn_global_load_lds((const unsigned*)((const char*)(gbase) + (voff)[_i]), (PG8_LAS unsigned*)(lds + (bufoff) + ldsw + _i * 8192), 16, 0, 0); } while (0)
#define PG8_LDA(dst, b, h) do { _Pragma("unroll") for (int m = 0; m < 4; ++m) _Pragma("unroll") for (int k = 0; k < 2; ++k) dst[m][k] = *(const PG8_LAS bf16x8*)(lds + PG8_SA(b, h) + aoff + m * 2048 + k * 1024); } while (0)
#define PG8_LDB(dst, b, h) do { _Pragma("unroll") for (int n = 0; n < 2; ++n) _Pragma("unroll") for (int k = 0; k < 2; ++k) dst[n][k] = *(const PG8_LAS bf16x8*)(lds + PG8_SB(b, h) + boff + n * 2048 + k * 1024); } while (0)
#define PG8_MMA(ai, bj, At, Bt) do { __builtin_amdgcn_s_setprio(1); _Pragma("unroll") for (int m = 0; m < 4; ++m) _Pragma("unroll") for (int n = 0; n < 2; ++n) _Pragma("unroll") for (int k = 0; k < 2; ++k) \
        acc[ai][bj][m][n] = __builtin_amdgcn_mfma_f32_16x16x32_bf16(Bt[n][k], At[m][k], acc[ai][bj][m][n], 0, 0, 0); __builtin_amdgcn_s_setprio(0); } while (0)
#define PG8_WAIT_V(n) asm volatile("s_waitcnt vmcnt(" #n ")" ::: "memory")
#define PG8_WAIT_L(n) asm volatile("s_waitcnt lgkmcnt(" #n ")" ::: "memory")
#define PG8_BAR __builtin_amdgcn_s_barrier()
#define PG8_SCHED __builtin_amdgcn_sched_barrier(0)
    Unit cur, nxt; int ui = 0;
    if (!S.next(0, cur)) return;
    f32x4 acc[2][2][4][2];
#pragma unroll
    for (int a = 0; a < 2; ++a)
#pragma unroll
        for (int b = 0; b < 2; ++b)
#pragma unroll
            for (int m = 0; m < 4; ++m)
#pragma unroll
                for (int n = 0; n < 2; ++n) acc[a][b][m][n] = (f32x4){0.f, 0.f, 0.f, 0.f};
    bf16x8 At[4][2], B0[2][2], B1[2][2];
    const char* cA = (const char*)g.A + (size_t)cur.pm * tstep; const char* cB = (const char*)g.Bt + (size_t)cur.pn * tstep;
    S.a_ready(cur);
    if constexpr (SP2) {
        PG8_STAGE(PG8_SB(0, 0), cB, voffB); PG8_STAGE(PG8_SB(0, 1), cB + hstep, voffB); PG8_STAGE(PG8_SA(0, 0), cA, voffA); PG8_STAGE(PG8_SA(0, 1), cA + hstep, voffA);
        if (wr == 1) PG8_BAR;
        PG8_WAIT_V(2); PG8_BAR;
        PG8_STAGE(PG8_SB(1, 0), cB + kstep, voffB); PG8_STAGE(PG8_SA(1, 0), cA + kstep, voffA); PG8_STAGE(PG8_SB(1, 1), cB + hstep + kstep, voffB);
        PG8_WAIT_V(6); PG8_BAR;
    } else {
        PG8_STAGE(PG8_SB(0, 0), cB, voffB); PG8_STAGE(PG8_SA(0, 0), cA, voffA); PG8_STAGE(PG8_SB(0, 1), cB + hstep, voffB); PG8_STAGE(PG8_SA(0, 1), cA + hstep, voffA);
        if (wr == 1) PG8_BAR;
        PG8_WAIT_V(4); PG8_BAR;
        PG8_STAGE(PG8_SB(1, 0), cB + kstep, voffB); PG8_STAGE(PG8_SA(1, 0), cA + kstep, voffA); PG8_STAGE(PG8_SB(1, 1), cB + hstep + kstep, voffB);
        PG8_WAIT_V(6); PG8_BAR;
    }
    for (;;) {
        const bool has_next = S.next(ui + 1, nxt);
        const char* nA = has_next ? (const char*)g.A + (size_t)nxt.pm * tstep : cA; const char* nB = has_next ? (const char*)g.Bt + (size_t)nxt.pn * tstep : cB;
        for (int t = 0; t < nt; t += 2) {
            const bool last = (t == nt - 2);
            const char* a1 = cA + (size_t)(t + 1) * kstep;
            const char* a2 = last ? nA : cA + (size_t)(t + 2) * kstep; const char* b2 = last ? nB : cB + (size_t)(t + 2) * kstep;
            const char* a3 = a2 + kstep; const char* b3 = b2 + kstep;
            if (last && has_next) S.a_ready(nxt);
            if constexpr (SP2) {
            PG8_LDB(B0, 0, 0); PG8_LDB(B1, 0, 1); PG8_SCHED; PG8_LDA(At, 0, 0); PG8_STAGE(PG8_SA(1, 1), a1 + hstep, voffA);
            PG8_WAIT_V(8); PG8_WAIT_L(0); PG8_BAR; PG8_MMA(0, 0, At, B0); PG8_MMA(0, 1, At, B1); PG8_BAR; PG8_SCHED;
            PG8_LDA(At, 0, 1); PG8_STAGE(PG8_SB(0, 0), b2, voffB); PG8_STAGE(PG8_SB(0, 1), b2 + hstep, voffB); PG8_STAGE(PG8_SA(0, 0), a2, voffA);
            PG8_WAIT_V(8); PG8_WAIT_L(0); PG8_BAR; PG8_MMA(1, 0, At, B0); PG8_MMA(1, 1, At, B1); PG8_BAR; PG8_SCHED;
            PG8_LDB(B0, 1, 0); PG8_LDB(B1, 1, 1); PG8_SCHED; PG8_LDA(At, 1, 0); PG8_STAGE(PG8_SA(0, 1), a2 + hstep, voffA);
            PG8_WAIT_V(8); PG8_WAIT_L(0); PG8_BAR; PG8_MMA(0, 0, At, B0); PG8_MMA(0, 1, At, B1); PG8_BAR; PG8_SCHED;
            PG8_LDA(At, 1, 1); PG8_STAGE(PG8_SB(1, 0), b3, voffB); PG8_STAGE(PG8_SB(1, 1), b3 + hstep, voffB); PG8_STAGE(PG8_SA(1, 0), a3, voffA);
            PG8_WAIT_V(8); PG8_WAIT_L(0); PG8_BAR; PG8_MMA(1, 0, At, B0); PG8_MMA(1, 1, At, B1); PG8_BAR; PG8_SCHED;
            } else {
            PG8_LDB(B0, 0, 0); PG8_SCHED; PG8_LDA(At, 0, 0); PG8_STAGE(PG8_SA(1, 1), a1 + hstep, voffA);
            PG8_WAIT_L(8); PG8_BAR; PG8_WAIT_L(0); PG8_MMA(0, 0, At, B0); PG8_BAR; PG8_SCHED;
            PG8_LDB(B1, 0, 1); PG8_STAGE(PG8_SB(0, 0), b2, voffB);
            PG8_BAR; PG8_WAIT_L(0); PG8_MMA(0, 1, At, B1); PG8_BAR;
            PG8_LDA(At, 0, 1); PG8_STAGE(PG8_SA(0, 0), a2, voffA);
            PG8_BAR; PG8_WAIT_L(0); PG8_MMA(1, 0, At, B0); PG8_BAR; PG8_SCHED;
            PG8_STAGE(PG8_SB(0, 1), b2 + hstep, voffB);
            PG8_WAIT_V(6); PG8_BAR; PG8_MMA(1, 1, At, B1); PG8_BAR;
            PG8_LDB(B0, 1, 0); PG8_SCHED; PG8_LDA(At, 1, 0); PG8_STAGE(PG8_SA(0, 1), a2 + hstep, voffA);
            PG8_WAIT_L(8); PG8_BAR; PG8_WAIT_L(0); PG8_MMA(0, 0, At, B0); PG8_BAR; PG8_SCHED;
            PG8_LDB(B1, 1, 1); PG8_STAGE(PG8_SB(1, 0), b3, voffB);
            PG8_BAR; PG8_WAIT_L(0); PG8_MMA(0, 1, At, B1); PG8_BAR;
            PG8_LDA(At, 1, 1); PG8_STAGE(PG8_SA(1, 0), a3, voffA);
            PG8_BAR; PG8_WAIT_L(0); PG8_MMA(1, 0, At, B0); PG8_BAR; PG8_SCHED;
            PG8_STAGE(PG8_SB(1, 1), b3 + hstep, voffB);
            PG8_WAIT_V(6); PG8_BAR; PG8_MMA(1, 1, At, B1); PG8_BAR;
            }
        }
        if constexpr (ALIGN_EPI) { if (wr == 0) PG8_BAR; }
        if constexpr (!Epi::AFTER_DRAIN) { E(acc, cur, wr, wc, fr, fq); S.done(cur); }
        if (!has_next) break;
#pragma unroll
        for (int a = 0; a < 2; ++a)
#pragma unroll
            for (int b = 0; b < 2; ++b)
#pragma unroll
                for (int m = 0; m < 4; ++m)
#pragma unroll
                    for (int n = 0; n < 2; ++n) acc[a][b][m][n] = (f32x4){0.f, 0.f, 0.f, 0.f};
        cur = nxt; cA = nA; cB = nB; ++ui;
        if constexpr (ALIGN_EPI) { if (wr == 1) PG8_BAR; }
    }
    PG8_WAIT_V(0);
    if constexpr (!ALIGN_EPI) { if (wr == 0) PG8_BAR; }
    PG8_BAR;
    if constexpr (Epi::AFTER_DRAIN) { E.fused(acc, cur, wr, wc, fr, fq, lds, wid, lane); S.done(cur); }
#undef PG8_SA
#undef PG8_SB
#undef PG8_STAGE
#undef PG8_LDA
#undef PG8_LDB
#undef PG8_MMA
#undef PG8_WAIT_V
#undef PG8_WAIT_L
#undef PG8_BAR
#undef PG8_SCHED
}
}
#define LAS __attribute__((address_space(3)))
#define XB_TMO      128
#define XB_XCNT(j)  (256  + 64 * (j))
#define XB_XSUB(j)  (1280 + 64 * (j))
#define XB_XGEN(j)  (2304 + 64 * (j))
#define XB_TOP      3328
#define XB_TOPGEN   3392
#define XCD_BAR_WORDS 3456
#define XB_SPIN_CAP (1u << 18)

__device__ __forceinline__ unsigned xb_ld(unsigned* p)              { return __hip_atomic_load(p, __ATOMIC_RELAXED, __HIP_MEMORY_SCOPE_AGENT); }
__device__ __forceinline__ unsigned xb_add(unsigned* p, unsigned v) { return __hip_atomic_fetch_add(p, v, __ATOMIC_RELAXED, __HIP_MEMORY_SCOPE_AGENT); }
__device__ __forceinline__ unsigned xb_xcc_id() { return (unsigned)__builtin_amdgcn_s_getreg((3 << 11) | 20) & 0xFu; }
#define XB_SPIN(cond, bar) do { unsigned _sp = 0; while (cond) { __builtin_amdgcn_s_sleep(1); \
    if ((++_sp & 255u) == 0u) { if (xb_ld(&(bar)[XB_TMO])) break; if (_sp > XB_SPIN_CAP) { atomicAdd(&(bar)[XB_TMO], 1u); break; } } } } while (0)

struct XcdBarrier {
    unsigned* bar; unsigned x;
    volatile LAS unsigned* st;
};

__device__ __forceinline__ XcdBarrier xcd_barrier_post(unsigned* bar, volatile LAS unsigned* st) {
    XcdBarrier b; b.bar = bar; b.x = xb_xcc_id(); b.st = st;
    if (threadIdx.x == 0) (void)xb_add(&bar[XB_XCNT(b.x)], 1u);
    return b;
}
__device__ __forceinline__ void xcd_barrier_complete(unsigned* bar, unsigned x, unsigned& nloc, unsigned& nx) {
    const unsigned G = gridDim.x * gridDim.y * gridDim.z;
    unsigned sum, cnt, mine, sp = 0u;
    for (;;) {
        sum = 0u; cnt = 0u; mine = 0u;
#pragma unroll
        for (unsigned j = 0; j < 16; ++j) { const unsigned c = xb_ld(&bar[XB_XCNT(j)]); sum += c; cnt += (c > 0u) ? 1u : 0u; mine = (j == x) ? c : mine; }
        if (sum == G) break;
        __builtin_amdgcn_s_sleep(1);
        if ((++sp & 255u) == 0u) { if (xb_ld(&bar[XB_TMO])) break; if (sp > XB_SPIN_CAP) { atomicAdd(&bar[XB_TMO], 1u); break; } }
    }
    nloc = mine > 0u ? mine : 1u; nx = cnt > 0u ? cnt : 1u;
}

__device__ __forceinline__ void xcd_barrier(const XcdBarrier& b) {
    asm volatile("s_waitcnt vmcnt(0)" ::: "memory");
    __syncthreads();
    if (threadIdx.x == 0) {
        unsigned* bar = b.bar;
        __builtin_amdgcn_s_waitcnt(0);
        unsigned nloc = b.st[0], nx = b.st[1];
        if (nloc == 0u) { xcd_barrier_complete(bar, b.x, nloc, nx); b.st[0] = nloc; b.st[1] = nx; }
        const unsigned old = xb_add(&bar[XB_XSUB(b.x)], 1u);
        const unsigned gen = old / nloc;
        if (old + 1u == (gen + 1u) * nloc) {
            __builtin_amdgcn_fence(__ATOMIC_RELEASE, "agent");
            asm volatile("s_waitcnt vmcnt(0)" ::: "memory");
            const unsigned og = xb_add(&bar[XB_TOP], 1u);
            const unsigned tg = og / nx;
            if (og + 1u == (tg + 1u) * nx) xb_add(&bar[XB_TOPGEN], 1u);
            else XB_SPIN(xb_ld(&bar[XB_TOPGEN]) == tg, bar);
            __builtin_amdgcn_fence(__ATOMIC_ACQUIRE, "agent");
            xb_add(&bar[XB_XGEN(b.x)], 1u);
            asm volatile("s_waitcnt vmcnt(0)" ::: "memory");
        } else {
            XB_SPIN(xb_ld(&bar[XB_XGEN(b.x)]) == gen, bar);
            __builtin_amdgcn_fence(__ATOMIC_ACQUIRE, "agent");
            asm volatile("s_waitcnt vmcnt(0)" ::: "memory");
        }
    }
    __syncthreads();
}
constexpr int DM = 2048, DEPTH = 4, NH = 8, HD = 128, DFF = 5632, NUP = 2 * DFF;
constexpr int INC = 7200, INP = 7424;
constexpr int TG = 65536, NGRP = 1, THALF = 32768;
#define EPS (oc(1e-6f))
constexpr int NWAVES = 8, NTHR = 512;
constexpr size_t MiB = 1u << 20;
constexpr size_t WS_CTL = 0, CTL_ZERO_BYTES = 128 * 1024;
constexpr int CW_XCH = 16384;
constexpr size_t WS_BIAS = 512 * 1024;
constexpr size_t WS_WIN = 1 * MiB, WS_WOUT = 30 * MiB, WS_WUP = 38 * MiB, WS_WDN = 82 * MiB;
constexpr size_t WS_H = 104 * MiB;
constexpr size_t WS_QKVA = 360 * MiB;
constexpr size_t WS_QKVD = 744 * MiB;
constexpr size_t WS_Z = 1128 * MiB;
constexpr size_t WS_GATES = 1256 * MiB;
constexpr size_t WS_BG = 1264 * MiB;
constexpr size_t WS_QKVN = 1272 * MiB;
constexpr size_t WS_OF = 1656 * MiB, WS_OB = 1784 * MiB;
constexpr size_t WS_MIX = WS_QKVN;
constexpr size_t WS_MIXED = WS_QKVA;
constexpr size_t WS_ATTP = WS_QKVD;
constexpr size_t WS_ATTML = 1912 * MiB;
constexpr size_t WS_GACT = 360 * MiB;
constexpr size_t WS_EDGE = 1128 * MiB;
constexpr size_t WS_F = 1272 * MiB;
__host__ __device__ __forceinline__ constexpr size_t ws_h(int) { return WS_H; }
constexpr size_t WS_SC = 1924 * MiB;
constexpr size_t WS_XCH = 1936 * MiB;
constexpr size_t XCH_BYTES = (size_t)2 * 256 * 2048 * 8;
constexpr size_t WS_END = WS_XCH + XCH_BYTES;
constexpr int CW_BAR = 1024;
constexpr int CW_ATTQ = 8192;
constexpr int RING_BYTES = 131072, LDS_BYTES = 163840, MISC_OFF = LDS_BYTES - 512;

#define GAS __attribute__((address_space(1)))
typedef unsigned short bf16;
typedef unsigned v4u __attribute__((ext_vector_type(4)));
typedef unsigned v2u __attribute__((ext_vector_type(2)));
typedef float f32x4 __attribute__((ext_vector_type(4)));
#define DI __device__ __forceinline__
DI int otid() { int t = threadIdx.x; asm volatile("" : "+v"(t)); return t; }
DI int obid() { int b = blockIdx.x; asm volatile("" : "+s"(b)); return b; }
DI float oc(float c) { asm volatile("" : "+v"(c)); return c; }
DI float shx(float v, int m) { return __builtin_bit_cast(float, __builtin_amdgcn_ds_bpermute(((otid() & 63) ^ m) << 2, __builtin_bit_cast(int, v))); }
DI void dma16(const void* g, LAS void* l) {
    asm volatile("s_mov_b32 m0, %1\n\ts_nop 0\n\tglobal_load_lds_dwordx4 %0, off" :: "v"(g), "s"((unsigned)(size_t)l) : "memory", "m0"); }
DI void dma16s(const void* sbase, unsigned voff, LAS void* l) {
    asm volatile("s_mov_b32 m0, %2\n\ts_nop 0\n\tglobal_load_lds_dwordx4 %0, %1" :: "v"(voff), "s"(sbase), "s"((unsigned)(size_t)l) : "memory", "m0"); }
template <int N> DI float row_ror(float x) { return __builtin_bit_cast(float, __builtin_amdgcn_mov_dpp(__builtin_bit_cast(int, x), 0x120 + N, 0xf, 0xf, true)); }
DI void plswap16(float& a, float& b) { asm volatile("s_nop 1\n\tv_permlane16_swap_b32 %0, %1\n\ts_nop 1" : "+v"(a), "+v"(b)); }
DI void plswap32(float& a, float& b) { asm volatile("s_nop 1\n\tv_permlane32_swap_b32 %0, %1\n\ts_nop 1" : "+v"(a), "+v"(b)); }
DI float xr_max(float x) { float a = x, b = x; plswap16(a, b); x = fmaxf(a, b); a = x; b = x; plswap32(a, b); return fmaxf(a, b); }
DI float xr_sum(float x) { float a = x, b = x; plswap16(a, b); x = a + b; a = x; b = x; plswap32(a, b); return a + b; }
DI float bf2f(unsigned v) { return __uint_as_float(v << 16); }
DI float bflo(unsigned w) { return __uint_as_float(w << 16); }
DI float bfhi(unsigned w) { return __uint_as_float(w & 0xffff0000u); }
typedef __bf16 bf16x2v __attribute__((ext_vector_type(2)));
typedef float f32x2v __attribute__((ext_vector_type(2)));
DI unsigned cvtpk(float lo, float hi) { return __builtin_bit_cast(unsigned, __builtin_convertvector((f32x2v){lo, hi}, bf16x2v)); }
DI unsigned pk2(float lo, float hi) { return cvtpk(lo, hi); }
DI unsigned f2bf(float f) { return cvtpk(f, 0.f) & 0xffffu; }
DI float wave_sum(float v) {
#pragma unroll
    for (int o = 1; o < 64; o <<= 1) v += shx(v, o);
    return v;
}
DI float siluf(float x) { return x / (1.f + __expf(-x)); }
DI size_t grow(int, int r) { return (size_t)r; }
DI void seq_of(int r, int& s0, int& L) { if (r < 32768) { s0 = r & ~4095; L = 4096; } else { s0 = 32768 + ((r - 32768) & ~8191); L = 8192; } }

struct Args { const float* in[18]; float* out; unsigned char* ws; int s_lo, s_hi; };
typedef const __attribute__((address_space(4))) Args CArgs;

DI void ph_bias(const float* rel_bias, float* tab) {
    const int i = obid() * NTHR + otid();
    if (i < 3 * 129 * 8) {
        const int br = i / (129 * 8), h = (i / 129) & 7, j = i % 129 - 64, d = br == 0 ? 1 : (br == 1 ? 4 : 16);
        const int rel = j * d, n = rel < 0 ? -rel : rel, base = rel > 0 ? 16 : 0;
        const float nf = (float)(n > 1 ? n : 1);
        int large = 8 + (int)(__builtin_amdgcn_logf(nf * 0.125f) * oc(8.f / 7.f)); large = large < 15 ? large : 15;
        const int bucket = base + (n < 8 ? n : large);
        tab[i] = rel_bias[bucket * 8 + h];
    }
}
DI void transpose_item(const float* W, int K, int N, bf16* WT, LAS float* scr, int item, int lane, int nscale, float scale, bool gatemap = false) {
    const int nblk = N / 32, kb = item / nblk, nb = item % nblk, k0 = 64 * kb, n0 = 32 * nb;
    int d0 = n0; if (gatemap) { const int ch = n0 >= DFF ? n0 - DFF : n0; d0 = 256 * (ch >> 7) + (n0 >= DFF ? 128 : 0) + (ch & 127); }
    const float sc = (n0 < nscale) ? scale : 1.f;
#pragma unroll 8
    for (int i = 0; i < 32; ++i) { const int kk = 2 * i + (lane >> 5); scr[kk * 33 + (lane & 31)] = W[(size_t)(k0 + kk) * N + n0 + (lane & 31)] * sc; }
    asm volatile("s_waitcnt lgkmcnt(0)" ::: "memory");
    const int c = lane & 7;
#pragma unroll
    for (int j = 0; j < 4; ++j) { const int n = (lane >> 3) + 8 * j; const LAS float* s = scr + (8 * c) * 33 + n;
        v4u o; o.x = pk2(s[0 * 33], s[1 * 33]); o.y = pk2(s[2 * 33], s[3 * 33]); o.z = pk2(s[4 * 33], s[5 * 33]); o.w = pk2(s[6 * 33], s[7 * 33]);
        *(v4u*)(WT + (size_t)(d0 + n) * K + k0 + 8 * c) = o; }
    asm volatile("s_waitcnt lgkmcnt(0)" ::: "memory");
}
DI void ph_weights(CArgs& a, int l, LAS unsigned char* lds) {
    const int tid = otid(), lane = tid & 63, wave = __builtin_amdgcn_readfirstlane(tid >> 6);
    LAS float* scr = (LAS float*)(lds + wave * 16384);
    const int gw = obid() * NWAVES + wave, NGW = gridDim.x * NWAVES;
    const float* Win = a.in[4] + (size_t)l * DM * INC; const float* Wout = a.in[10] + (size_t)l * DM * DM;
    const float* Wup = a.in[13] + (size_t)l * DM * NUP; const float* Wdn = a.in[16] + (size_t)l * DFF * DM;
    bf16* Tin = (bf16*)(a.ws + WS_WIN); bf16* Tout = (bf16*)(a.ws + WS_WOUT); bf16* Tup = (bf16*)(a.ws + WS_WUP); bf16* Tdn = (bf16*)(a.ws + WS_WDN);
    constexpr int I_IN = (DM / 64) * (INC / 32), I_OUT = (DM / 64) * (DM / 32), I_UP = (DM / 64) * (NUP / 32), I_DN = (DFF / 64) * (DM / 32);
    for (int it = gw; it < I_IN + I_OUT + I_UP + I_DN; it += NGW) {
        int r = it;
        if (r < I_IN) { transpose_item(Win, DM, INC, Tin, scr, r, lane, 1024, oc(0.08838834764831845f)); continue; } r -= I_IN;
        if (r < I_OUT) { transpose_item(Wout, DM, DM, Tout, scr, r, lane, 0, 1.f); continue; } r -= I_OUT;
        if (r < I_UP) { transpose_item(Wup, DM, NUP, Tup, scr, r, lane, 0, 1.f, true); continue; } r -= I_UP;
        transpose_item(Wdn, DFF, DM, Tdn, scr, r, lane, 0, 1.f);
    }
    v4u* z = (v4u*)(Tin + (size_t)INC * DM); const int nz = (INP - INC) * DM / 8;
    const unsigned z0 = (unsigned)otid() >> 31;
    for (int i = obid() * NTHR + tid; i < nz; i += gridDim.x * NTHR) z[i] = (v4u){z0, z0, z0, z0};
}
DI void load_xrow(CArgs& a, int l, size_t R, int lane, f32x4 (&v)[8]) {
    if (l == 0) { const f32x4* x = (const f32x4*)((int)R < 32768 ? a.in[0] + R * DM : a.in[1] + (R - 32768) * DM);
#pragma unroll
        for (int j = 0; j < 8; ++j) v[j] = x[lane + 64 * j]; }
    else { const v2u* x = (const v2u*)(a.out + R * DM);
#pragma unroll
        for (int j = 0; j < 8; ++j) { const v2u w = x[lane + 64 * j]; v[j] = (f32x4){bflo(w.x), bfhi(w.x), bflo(w.y), bfhi(w.y)}; } }
}
DI float sumsq8(const f32x4 (&v)[8]) { float s = 0.f;
#pragma unroll
    for (int j = 0; j < 8; ++j) s += (v[j].x * v[j].x + v[j].y * v[j].y) + (v[j].z * v[j].z + v[j].w * v[j].w);
    return s; }
DI void cvt_row(const v2u (&w)[8], f32x4 (&v)[8]) {
#pragma unroll
    for (int j = 0; j < 8; ++j) v[j] = (f32x4){bflo(w[j].x), bfhi(w[j].x), bflo(w[j].y), bfhi(w[j].y)}; }
DI void ld_row_bf16(const bf16* rowp, int lane, v2u (&w)[8]) { const v2u* p = (const v2u*)rowp;
#pragma unroll
    for (int j = 0; j < 8; ++j) w[j] = __builtin_nontemporal_load(p + lane + 64 * j); }
DI void st_row_bf16(bf16* rowp, int lane, const f32x4 (&v)[8], float sc, const f32x4* gain) { v2u* o = (v2u*)rowp;
#pragma unroll
    for (int j = 0; j < 8; ++j) { const f32x4 gg = gain[lane + 64 * j]; v2u w; w.x = cvtpk(v[j].x * sc * gg.x, v[j].y * sc * gg.y); w.y = cvtpk(v[j].z * sc * gg.z, v[j].w * sc * gg.w); o[lane + 64 * j] = w; } }
DI void ph_prenorm(CArgs& a, int l, int g) {
    const int lane = otid() & 63, wave = __builtin_amdgcn_readfirstlane(otid() >> 6), gw = obid() * NWAVES + wave, NGW = gridDim.x * NWAVES;
    const f32x4* gain = (const f32x4*)(a.in[3] + (size_t)l * DM); bf16* H = (bf16*)(a.ws + ws_h(g));
    for (int r = gw; r < TG; r += 2 * NGW) {
        const int r1 = r + NGW;
        f32x4 va[8], vb[8]; load_xrow(a, l, grow(g, r), lane, va); load_xrow(a, l, grow(g, r1), lane, vb);
        st_row_bf16(H + (size_t)r * DM, lane, va, rsqrtf(wave_sum(sumsq8(va)) * (1.f / DM) + EPS), gain);
        st_row_bf16(H + (size_t)r1 * DM, lane, vb, rsqrtf(wave_sum(sumsq8(vb)) * (1.f / DM) + EPS), gain);
        { v2u* xa_ = (v2u*)(a.out + grow(g, r) * DM); v2u* xb_ = (v2u*)(a.out + grow(g, r1) * DM);
#pragma unroll
          for (int j = 0; j < 8; ++j) { v2u w; w.x = cvtpk(va[j].x, va[j].y); w.y = cvtpk(va[j].z, va[j].w); xa_[lane + 64 * j] = w; w.x = cvtpk(vb[j].x, vb[j].y); w.y = cvtpk(vb[j].z, vb[j].w); xb_[lane + 64 * j] = w; } }
    }
}
template <int PV> DI void postmix_row(CArgs& a, int g, int r, size_t R, int lane, const v2u (&mw)[8], f32x4 (&x)[8], const f32x4* g1, const f32x4* g2) {
    f32x4 v[8]; cvt_row(mw, v);
    const float rinv = PV == 3 ? ((const float*)(a.ws + WS_XCH + 4 * MiB))[r] : rsqrtf(wave_sum(sumsq8(v)) * (1.f / DM) + EPS);
    v2u* xo = PV == 1 ? (v2u*)((bf16*)(a.ws + WS_QKVN) + R * DM) : (v2u*)(a.out + R * DM);
#pragma unroll
    for (int j = 0; j < 8; ++j) { const f32x4 gg = g1[lane + 64 * j]; x[j] = x[j] + v[j] * rinv * gg; v2u w; w.x = cvtpk(x[j].x, x[j].y); w.y = cvtpk(x[j].z, x[j].w); xo[lane + 64 * j] = w; }
    st_row_bf16((bf16*)(a.ws + ((PV == 1 || PV == 2) ? WS_QKVD : ws_h(g))) + (size_t)r * DM, lane, x, PV == 3 ? ((const float*)(a.ws + WS_XCH + 4 * MiB))[TG + r] : rsqrtf(wave_sum(sumsq8(x)) * (1.f / DM) + EPS), g2);
}
template <int PV> DI void ph_postmix(CArgs& a, int l, int g) {
    const int lane = otid() & 63, wave = __builtin_amdgcn_readfirstlane(otid() >> 6), gw = obid() * NWAVES + wave, NGW = gridDim.x * NWAVES;
    const f32x4* g1 = (const f32x4*)(a.in[11] + (size_t)l * DM); const f32x4* g2 = (const f32x4*)(a.in[12] + (size_t)l * DM);
    const bf16* MX = (const bf16*)(a.ws + WS_MIXED);
    for (int r = gw; r < TG; r += 2 * NGW) {
        const int r1 = r + NGW; const size_t R = grow(g, r), R1 = grow(g, r1);
        v2u ma[8], mb[8]; f32x4 xa[8], xb[8];
        ld_row_bf16(MX + (size_t)r * DM, lane, ma); load_xrow(a, l, R, lane, xa); ld_row_bf16(MX + (size_t)r1 * DM, lane, mb); load_xrow(a, l, R1, lane, xb);
        postmix_row<PV>(a, g, r, R, lane, ma, xa, g1, g2); postmix_row<PV>(a, g, r1, R1, lane, mb, xb, g1, g2);
    }
}
template <int PV> DI void postffn_row(CArgs& a, int l, int g, int r, size_t R, int lane, const v2u (&fw)[8], const v2u (&xw)[8], const f32x4* g1) {
    f32x4 v[8], x[8]; cvt_row(fw, v); cvt_row(xw, x);
    const float rinv = rsqrtf(wave_sum(sumsq8(v)) * (1.f / DM) + EPS);
#pragma unroll
    for (int j = 0; j < 8; ++j) { const f32x4 gg = g1[lane + 64 * j]; v[j] = x[j] + v[j] * rinv * gg; }
    if (l == DEPTH - 1) { f32x4* xo = PV ? (f32x4*)((float*)(a.ws + WS_QKVA) + R * DM) : (f32x4*)(a.out + R * DM);
#pragma unroll
        for (int j = 0; j < 8; ++j) xo[lane + 64 * j] = v[j]; }
    else { v2u* xo = PV ? (v2u*)((bf16*)(a.ws + WS_QKVA) + R * DM) : (v2u*)(a.out + R * DM);
#pragma unroll
        for (int j = 0; j < 8; ++j) { v2u w; w.x = cvtpk(v[j].x, v[j].y); w.y = cvtpk(v[j].z, v[j].w); xo[lane + 64 * j] = w; }
        st_row_bf16((bf16*)(a.ws + (PV ? WS_QKVD : ws_h(g))) + (size_t)r * DM, lane, v, rsqrtf(wave_sum(sumsq8(v)) * (1.f / DM) + EPS), (const f32x4*)(a.in[3] + (size_t)(l + 1) * DM)); }
}
template <int PV> DI void ph_postffn(CArgs& a, int l, int g) {
    const int lane = otid() & 63, wave = __builtin_amdgcn_readfirstlane(otid() >> 6), gw = obid() * NWAVES + wave, NGW = gridDim.x * NWAVES;
    const f32x4* g1 = (const f32x4*)(a.in[17] + (size_t)l * DM); const bf16* FB = (const bf16*)(a.ws + WS_F);
    for (int r = gw; r < TG; r += 2 * NGW) {
        const int r1 = r + NGW; const size_t R = grow(g, r), R1 = grow(g, r1);
        v2u fa[8], fb[8], xa[8], xb[8];
        ld_row_bf16(FB + (size_t)r * DM, lane, fa); ld_row_bf16((const bf16*)(a.out + R * DM), lane, xa); ld_row_bf16(FB + (size_t)r1 * DM, lane, fb); ld_row_bf16((const bf16*)(a.out + R1 * DM), lane, xb);
        postffn_row<PV>(a, l, g, r, R, lane, fa, xa, g1); postffn_row<PV>(a, l, g, r1, R1, lane, fb, xb, g1);
    }
}
DI void ph_attn_simple(CArgs& a, int l) {
    const int lane = otid() & 63, wave = __builtin_amdgcn_readfirstlane(otid() >> 6), gw = obid() * NWAVES + wave, NGW = gridDim.x * NWAVES;
    const int ks = lane >> 4, dg = lane & 15;
    const bf16* QA = (const bf16*)(a.ws + WS_QKVA); bf16* MIX = (bf16*)(a.ws + WS_MIX);
    const float* tab = (const float*)(a.ws + WS_BIAS); const float* gain = a.in[8] + (size_t)l * HD;
    float gn[8];
#pragma unroll
    for (int i = 0; i < 8; ++i) gn[i] = gain[dg * 8 + i];
    for (int task = gw; task < TG * NH; task += NGW) {
        const int r = task >> 3, h = task & 7; int s0, L; seq_of(r, s0, L); const int p = r - s0;
        float q[8]; { const v4u w = *(const v4u*)(QA + (size_t)r * 3072 + h * HD + dg * 8);
            q[0] = bflo(w.x); q[1] = bfhi(w.x); q[2] = bflo(w.y); q[3] = bfhi(w.y); q[4] = bflo(w.z); q[5] = bfhi(w.z); q[6] = bflo(w.w); q[7] = bfhi(w.w); }
        float m = -1e30f, den = 0.f, o[8];
#pragma unroll
        for (int i = 0; i < 8; ++i) o[i] = 0.f;
        for (int br = 0; br < 3; ++br) {
            const int d = br == 0 ? 1 : (br == 1 ? 4 : 16);
            for (int it = 0; it < 33; ++it) {
                const int j = -64 + 4 * it + ks, pos = p + j * d;
                const bool valid = (j <= 64) && pos >= 0 && pos < L;
                float part = 0.f; const bf16* krow = QA + (size_t)(s0 + (valid ? pos : p)) * 3072 + h * HD + dg * 8;
                if (valid) { const v4u w = *(const v4u*)(krow + 1024);
                    part = q[0] * bflo(w.x) + q[1] * bfhi(w.x) + q[2] * bflo(w.y) + q[3] * bfhi(w.y) + q[4] * bflo(w.z) + q[5] * bfhi(w.z) + q[6] * bflo(w.w) + q[7] * bfhi(w.w); }
                part += shx(part, 1); part += shx(part, 2); part += shx(part, 4); part += shx(part, 8);
                if (valid) {
                    const float s = part + tab[(br * 8 + h) * 129 + (j + 64)];
                    const float mn = fmaxf(m, s), sc = __expf(m - mn), pw = __expf(s - mn);
                    const v4u w = *(const v4u*)(krow + 2048);
                    den = den * sc + pw; m = mn;
                    o[0] = o[0] * sc + pw * bflo(w.x); o[1] = o[1] * sc + pw * bfhi(w.x); o[2] = o[2] * sc + pw * bflo(w.y); o[3] = o[3] * sc + pw * bfhi(w.y);
                    o[4] = o[4] * sc + pw * bflo(w.z); o[5] = o[5] * sc + pw * bfhi(w.z); o[6] = o[6] * sc + pw * bflo(w.w); o[7] = o[7] * sc + pw * bfhi(w.w);
                }
            }
        }
        float ma = fmaxf(m, shx(m, 16)); ma = fmaxf(ma, shx(ma, 32));
        const float wg = __expf(m - ma);
        den *= wg; den += shx(den, 16); den += shx(den, 32);
        const float inv = 1.f / den; float ss = 0.f;
#pragma unroll
        for (int i = 0; i < 8; ++i) { float v = o[i] * wg; v += shx(v, 16); v += shx(v, 32); o[i] = v * inv; ss += o[i] * o[i]; }
        ss += shx(ss, 1); ss += shx(ss, 2); ss += shx(ss, 4); ss += shx(ss, 8);
        const float rinv = rsqrtf(ss * (1.f / HD) + EPS);
        if (ks == 0) { v4u w; w.x = pk2(o[0] * rinv * gn[0], o[1] * rinv * gn[1]); w.y = pk2(o[2] * rinv * gn[2], o[3] * rinv * gn[3]);
            w.z = pk2(o[4] * rinv * gn[4], o[5] * rinv * gn[5]); w.w = pk2(o[6] * rinv * gn[6], o[7] * rinv * gn[7]);
            *(v4u*)(MIX + (size_t)r * DM + h * HD + dg * 8) = w; }
    }
}

typedef short bf16x8 __attribute__((ext_vector_type(8)));
typedef short s16x4 __attribute__((ext_vector_type(4)));
typedef float f32x16 __attribute__((ext_vector_type(16)));
#define MFMA16(a, b, c) __builtin_amdgcn_mfma_f32_16x16x32_bf16((a), (b), (c), 0, 0, 0)
#define MFMA32(a, b, c) __builtin_amdgcn_mfma_f32_32x32x16_bf16((a), (b), (c), 0, 0, 0)
constexpr int VP = 272;
constexpr int ATT_WAVE_LDS = 32 * VP + 576;
DI void ph_attn_mfma(CArgs& a, LAS unsigned char* lds) {
    const int lane = otid() & 63, wave = __builtin_amdgcn_readfirstlane(otid() >> 6), gw = obid() * NWAVES + wave, NGW = gridDim.x * NWAVES;
    const int h5 = lane >> 5, ql = lane & 31;
    const bf16* QA = (const bf16*)(a.ws + WS_QKVA);
    const float* tab = (const float*)(a.ws + WS_BIAS);
    LAS unsigned char* vl = lds + wave * ATT_WAVE_LDS; LAS float* bl = (LAS float*)(vl + 32 * VP);
    const int i16 = lane & 15, q4 = i16 >> 2, p4 = i16 & 3, blk = (lane >> 4) & 1;
    for (int task = gw; task < 3 * 8192; task += NGW) {
        const int br = task >> 13, rem = task & 8191, h = rem >> 10, bidx = rem & 1023;
        const int d = br == 0 ? 1 : (br == 1 ? 4 : 16);
        int s0, L, within; if (bidx < 512) { s0 = (bidx >> 7) * 4096; L = 4096; within = bidx & 127; } else { s0 = 16384 + ((bidx - 512) >> 8) * 8192; L = 8192; within = (bidx - 512) & 255; }
        const int nsub = L / d, nqb = nsub >> 5, res = within / nqb, qb = within % nqb;
        for (int i = lane; i < 129; i += 64) bl[i] = tab[(br * 8 + h) * 129 + i];
        const bf16* base = QA + (size_t)(s0 + res) * 3072 + h * HD + 8 * h5;
        bf16x8 qf[8];
        { const bf16* qp = base + (size_t)(32 * qb + ql) * d * 3072;
#pragma unroll
          for (int ks = 0; ks < 8; ++ks) qf[ks] = *(const bf16x8*)(qp + 16 * ks); }
        f32x16 S[5];
#pragma unroll
        for (int kb = 0; kb < 5; ++kb) {
#pragma unroll
            for (int i = 0; i < 16; ++i) S[kb][i] = 0.f;
            const int mk0 = 32 * (qb + kb - 2);
            if (mk0 >= 0 && mk0 < nsub) {
                const bf16* kp = base + 1024 + (size_t)(mk0 + ql) * d * 3072;
                bf16x8 kf[8];
#pragma unroll
                for (int ks = 0; ks < 8; ++ks) kf[ks] = *(const bf16x8*)(kp + 16 * ks);
#pragma unroll
                for (int ks = 0; ks < 8; ++ks) S[kb] = MFMA32(kf[ks], qf[ks], S[kb]);
            }
        }
        float m = -1e30f;
#pragma unroll
        for (int kb = 0; kb < 5; ++kb) { const int mk0 = 32 * (qb + kb - 2); const bool bv = (mk0 >= 0 && mk0 < nsub);
#pragma unroll
            for (int i = 0; i < 16; ++i) { const int idx = 32 * kb + (i & 3) + 8 * (i >> 2) + 4 * h5 - ql; const bool ok = bv && idx >= 0 && idx <= 128;
                const float v = ok ? S[kb][i] + bl[ok ? idx : 0] : -1e30f; S[kb][i] = v; m = fmaxf(m, v); } }
        m = fmaxf(m, shx(m, 32));
        float den = 0.f;
#pragma unroll
        for (int kb = 0; kb < 5; ++kb)
#pragma unroll
            for (int i = 0; i < 16; ++i) { const float v = S[kb][i]; const float p = v > -1e29f ? __expf(v - m) : 0.f; S[kb][i] = p; den += p; }
        den += shx(den, 32);
        f32x16 O[4];
#pragma unroll
        for (int db = 0; db < 4; ++db)
#pragma unroll
            for (int i = 0; i < 16; ++i) O[db][i] = 0.f;
#pragma unroll
        for (int kb = 0; kb < 5; ++kb) {
            const int mk0 = 32 * (qb + kb - 2);
            if (mk0 >= 0 && mk0 < nsub) {
                v4u vr[8];
#pragma unroll
                for (int it = 0; it < 8; ++it) { const int row = 4 * it + (lane >> 4);
                    vr[it] = *(const v4u*)(QA + (size_t)(s0 + res + (size_t)(mk0 + row) * d) * 3072 + 2048 + h * HD + 8 * (lane & 15)); }
#pragma unroll
                for (int it = 0; it < 8; ++it) { const int row = 4 * it + (lane >> 4); *(LAS v4u*)(vl + row * VP + 16 * (lane & 15)) = vr[it]; }
#pragma unroll
                for (int s = 0; s < 2; ++s) {
                    v4u pw; pw.x = cvtpk(S[kb][8 * s + 0], S[kb][8 * s + 1]); pw.y = cvtpk(S[kb][8 * s + 2], S[kb][8 * s + 3]); pw.z = cvtpk(S[kb][8 * s + 4], S[kb][8 * s + 5]); pw.w = cvtpk(S[kb][8 * s + 6], S[kb][8 * s + 7]);
                    const bf16x8 pf = __builtin_bit_cast(bf16x8, pw);
#pragma unroll
                    for (int db = 0; db < 4; ++db) {
                        const s16x4 lo = __builtin_amdgcn_ds_read_tr16_b64_v4i16((LAS s16x4*)(vl + (16 * s + 4 * h5 + q4) * VP + (32 * db + 16 * blk + 4 * p4) * 2));
                        const s16x4 hi = __builtin_amdgcn_ds_read_tr16_b64_v4i16((LAS s16x4*)(vl + (16 * s + 8 + 4 * h5 + q4) * VP + (32 * db + 16 * blk + 4 * p4) * 2));
                        const bf16x8 vf = __builtin_shufflevector(lo, hi, 0, 1, 2, 3, 4, 5, 6, 7);
                        O[db] = MFMA32(vf, pf, O[db]);
                    }
                }
            }
        }
        const float inv = 1.f / den; const size_t row = (size_t)(s0 + res) + (size_t)(32 * qb + ql) * d;
        bf16* op = (bf16*)(a.ws + WS_ATTP) + ((size_t)br * TG + row) * 1024 + h * HD + 4 * h5;
#pragma unroll
        for (int db = 0; db < 4; ++db)
#pragma unroll
            for (int i4 = 0; i4 < 4; ++i4) { v2u w; w.x = cvtpk(O[db][4 * i4] * inv, O[db][4 * i4 + 1] * inv); w.y = cvtpk(O[db][4 * i4 + 2] * inv, O[db][4 * i4 + 3] * inv);
                *(v2u*)(op + 32 * db + 8 * i4) = w; }
        if (h5 == 0) { float* ml = (float*)(a.ws + WS_ATTML) + (((size_t)br * TG + row) * 8 + h) * 2; *(f32x2v*)ml = (f32x2v){m, den}; }
    }
}
DI bf16x8 pack8(const f32x4 lo, const f32x4 hi) { v4u p; p.x = cvtpk(lo[0], lo[1]); p.y = cvtpk(lo[2], lo[3]); p.z = cvtpk(hi[0], hi[1]); p.w = cvtpk(hi[2], hi[3]); return __builtin_bit_cast(bf16x8, p); }

struct AttnTile { int br, h, d, s0, nsub, res, mq0; };
DI AttnTile attn_decode(int tile) {
    AttnTile T; T.h = tile / 1536; int r = tile - T.h * 1536, L, within;
    if (r < 768) { const int sq = r / 96, rr = r - sq * 96; T.s0 = sq * 4096; L = 4096; T.br = rr >> 5; within = rr & 31; }
    else { r -= 768; const int sq = r / 192, rr = r - sq * 192; T.s0 = 32768 + sq * 8192; L = 8192; T.br = rr >> 6; within = rr & 63; }
    T.d = 1 << (2 * T.br);
    const int lgd = 2 * T.br, lgn = (L == 4096 ? 5 : 6) - lgd; T.nsub = L >> lgd; T.res = within >> lgn; T.mq0 = (within & ((1 << lgn) - 1)) << 7; return T;
}
constexpr int NATT = 3 * NH * (TG / 128);
template <int AV> DI void ph_attn2(CArgs& a, LAS unsigned char* lds, int l, int g, int qset = 0) {
    const int t = otid(), lane = t & 63, wave = __builtin_amdgcn_readfirstlane(t >> 6), ql = lane & 15, g4 = lane >> 4, q4 = ql >> 2, p4 = ql & 3;
    LAS unsigned char* Ki = lds; LAS unsigned char* Vi = lds + 65536;
    LAS float* bl0 = (LAS float*)(lds + 131072 + 1024); LAS float* bl12 = (LAS float*)(lds + 131072 + 4096 + 8 * 2048);
    LAS int* tqw = (LAS int*)(lds + 131072 + 512);
    int cur_h = -1;
    const unsigned dmaL0 = (unsigned)(((lane & 15) ^ (2 * g4)) * 16), dmaL1 = dmaL0 ^ 128u;
    unsigned kL[4], vL[8];
#pragma unroll
    for (int ks = 0; ks < 4; ++ks) kL[ks] = (unsigned)(ql * 256 + (((4 * ks + g4) ^ (2 * (ql & 7))) * 16));
    { const int vr = 4 * g4 + q4;
#pragma unroll
      for (int db = 0; db < 8; ++db) vL[db] = (unsigned)(vr * 256 + (((2 * db + (p4 >> 1)) ^ (2 * (vr & 7))) * 16) + 8 * (p4 & 1)); }
    const bf16* QA = (const bf16*)(a.ws + WS_QKVA); const float* tab = (const float*)(a.ws + WS_BIAS);
    unsigned* cntb = (unsigned*)(a.ws + WS_CTL) + CW_ATTQ + 64 * 8 * (qset * 8 + l * NGRP + g);
    const int xme = (int)(xb_xcc_id() & 7u);
    constexpr int NPAIR = NATT / 2, N8 = NPAIR / 8;
    int xq = 0;
#define ATT_FETCH(raw_, q_) do { q_ = xq < 8 ? xq : 7; raw_ = (int)__hip_atomic_fetch_add(cntb + 64 * ((xme + q_) & 7), 1u, __ATOMIC_RELAXED, __HIP_MEMORY_SCOPE_AGENT); } while (0)
    auto resolve = [&](int raw, int q) -> int {
        if (raw < N8) return ((xme + q) & 7) * N8 + raw;
        for (int qq = (xq > q + 1 ? xq : q + 1); qq < 8; ++qq) { const int i = (int)__hip_atomic_fetch_add(cntb + 64 * ((xme + qq) & 7), 1u, __ATOMIC_RELAXED, __HIP_MEMORY_SCOPE_AGENT); if (i < N8) { xq = qq; return ((xme + qq) & 7) * N8 + i; } }
        xq = 8; return NPAIR; };
    int nxt = 0, nxtq = 0;
    if (t == 0) { int r0_, q0_; ATT_FETCH(r0_, q0_); tqw[0] = resolve(r0_, q0_); ATT_FETCH(nxt, nxtq); }
    __syncthreads();
    int tile = 2 * tqw[0];
#define ATT_IMG(T_, sec_, cofs, dst, en) do { const unsigned char* gb_ = (const unsigned char*)(QA + (size_t)((T_).s0 + (T_).res) * 3072 + (T_).h * HD) + (cofs); \
        const int lgd_ = 2 * (T_).br, kofs_ = (T_).mq0 - 64 + ((sec_) ? 128 : 0), i0_ = ((sec_) ? 4 : 8) * wave; \
        if (!(((T_).mq0 < 64) || ((T_).mq0 + 192 > (T_).nsub))) { const unsigned lrow_ = (unsigned)(g4 * 6144) << lgd_; const unsigned l0_ = lrow_ + dmaL0, l1_ = lrow_ + dmaL1; \
            _Pragma("unroll") for (int u = 0; u < 8; ++u) { if (!(sec_) || u < 4) { const int i = i0_ + u; const unsigned ub_ = (unsigned)((kofs_ + 4 * i) * 6144) << lgd_; \
                if (en) dma16s(gb_, ((u & 1) ? l1_ : l0_) + ub_, (dst) + i * 1024); } } } \
        else { _Pragma("unroll") for (int u = 0; u < 8; ++u) { if (!(sec_) || u < 4) { const int i = i0_ + u; int m = kofs_ + 4 * i + g4; m = m < 0 ? 0 : (m > (T_).nsub - 1 ? (T_).nsub - 1 : m); \
                if (en) dma16s(gb_, ((unsigned)(m * 6144) << lgd_) + ((u & 1) ? dmaL1 : dmaL0), (dst) + i * 1024); } } } } while (0)
#define ATT_ISSUE_KQ(T_, qdst, sec_) do { ATT_IMG(T_, sec_, 2048, Ki, true); \
        const bf16* qp_ = QA + (size_t)((T_).s0 + (T_).res) * 3072 + (T_).h * HD + (size_t)((T_).mq0 + 16 * wave + ql) * (T_).d * 3072 + 8 * g4; \
        _Pragma("unroll") for (int ks = 0; ks < 4; ++ks) qdst[ks] = *(const bf16x8*)(qp_ + 32 * ks); } while (0)
    bf16x8 qf[4];
    if (tile < NATT) { const AttnTile T0 = attn_decode(tile); ATT_ISSUE_KQ(T0, qf, 0); }
    { unsigned* dmy = (unsigned*)(a.ws + WS_CTL + 768 * 1024) + t;
#pragma unroll
      for (int i = 0; i < 5; ++i) __builtin_nontemporal_store(0u, dmy + 512 * i); }
    while (tile < NATT) {
        const AttnTile T = attn_decode(tile);
        const int br = T.br, h = T.h, d = T.d, s0 = T.s0, nsub = T.nsub, res = T.res, mq0 = T.mq0;
        if (h != cur_h) { cur_h = h;
            for (int i = t; i < 3 * 4 * 192; i += NTHR) { const int b = i / 768, ii = i - b * 768, c = ii / 192, j = ii % 192, k = j + c - 16;
                (b == 0 ? bl0 : bl12 + (b - 1) * 768)[ii] = (k >= 0 && k < 129) ? tab[(b * 8 + h) * 129 + k] : -1e30f; } }
        const LAS float* bl = br == 0 ? bl0 : bl12 + (br - 1) * 768;
        const int sec = tile & 1;
        if (t == 0 && sec) tqw[1] = resolve(nxt, nxtq);
        const bf16* sbase = QA + (size_t)(s0 + res) * 3072 + h * HD;
        asm volatile("s_waitcnt vmcnt(5) lgkmcnt(0)" : "+v"(qf[0]), "+v"(qf[1]), "+v"(qf[2]), "+v"(qf[3]) :: "memory"); __builtin_amdgcn_s_barrier(); asm volatile("" ::: "memory");
        int nn2 = 0, nn2q = 0; if (t == 0 && sec) ATT_FETCH(nn2, nn2q);
        ATT_IMG(T, sec, 4096, Vi, !(AV & 16));
        const int ntile = sec ? 2 * tqw[1] : tile + 1;
        const int roff = sec ? 128 : 0;
        const bool edge_tile = (mq0 < 64) || (mq0 + 192 > nsub);
        const size_t qrow = (size_t)(s0 + res) + (size_t)(mq0 + 16 * wave + ql) * d;
        f32x4 S[9];
        bf16x8 ka[2][4];
#define LDK4(dst, kb) do { const unsigned rb_ = (unsigned)(((16 * (wave + (kb)) + roff) & 255) * 256); _Pragma("unroll") for (int ks = 0; ks < 4; ++ks) dst[ks] = *(const LAS bf16x8*)(Ki + rb_ + kL[ks]); } while (0)
        LDK4(ka[0], 0);
#pragma unroll
        for (int kb = 0; kb < 9; ++kb) {
            if (kb + 1 < 9) LDK4(ka[(kb + 1) & 1], kb + 1);
            __builtin_amdgcn_sched_barrier(0);
            S[kb] = (f32x4){0.f, 0.f, 0.f, 0.f};
#pragma unroll
            for (int ks = 0; ks < 4; ++ks) if (!(AV & 1)) S[kb] = MFMA16(ka[kb & 1][ks], qf[ks], S[kb]);
            __builtin_amdgcn_sched_barrier(0);
        }
#undef LDK4
        float mx = -1e30f;
        { const int a0 = 4 * g4 - ql + 16, c = a0 & 3;
          const LAS float* bc = bl + 192 * c + (a0 - c);
          if (!edge_tile) {
#pragma unroll
            for (int kb = 0; kb < 9; ++kb) {
              const f32x4 b4 = (AV & 8) ? (f32x4){0.f, 0.f, 0.f, 0.f} : *(const LAS f32x4*)(bc + 16 * kb);
#pragma unroll
              for (int i = 0; i < 4; ++i) { const float v = S[kb][i] + b4[i]; S[kb][i] = v; mx = fmaxf(mx, v); } }
          } else {
            const int lo = 64 - mq0 - 16 * wave - 4 * g4; const unsigned rng = (unsigned)(nsub - 1);
#pragma unroll
            for (int kb = 0; kb < 9; ++kb) {
              const f32x4 b4 = (AV & 8) ? (f32x4){0.f, 0.f, 0.f, 0.f} : *(const LAS f32x4*)(bc + 16 * kb);
#pragma unroll
              for (int i = 0; i < 4; ++i) { const float sb = S[kb][i] + b4[i]; const float v = ((unsigned)(16 * kb + i - lo) <= rng) ? sb : -1e30f; S[kb][i] = v; mx = fmaxf(mx, v); } }
          } }
        mx = xr_max(mx);
        float den = 0.f;
        { const float mxs = -mx * 1.44269504f;
#pragma unroll
          for (int kb = 0; kb < 9; ++kb)
#pragma unroll
            for (int i = 0; i < 4; ++i) { if (!(AV & 2)) { const float p = __builtin_amdgcn_exp2f(__builtin_fmaf(S[kb][i], 1.44269504f, mxs)); S[kb][i] = p; den += p; } else den += 1.f; } }
        den = xr_sum(den);
        asm volatile("s_waitcnt vmcnt(0) lgkmcnt(0)" ::: "memory"); __builtin_amdgcn_s_barrier(); asm volatile("" ::: "memory");
        if (!(AV & 16) && ntile < NATT) { const AttnTile Tn = attn_decode(ntile); ATT_ISSUE_KQ(Tn, qf, (ntile & 1)); }
        f32x4 O[8];
#pragma unroll
        for (int db = 0; db < 8; ++db) O[db] = (f32x4){0.f, 0.f, 0.f, 0.f};
        s16x4 va[2][16];
#define LDV16(dst, s) do { const unsigned blo_ = (unsigned)(((16 * (wave + 2 * (s)) + roff) & 255) * 256), bhi_ = (2 * (s) + 1 < 9) ? (unsigned)(((16 * (wave + 2 * (s) + 1) + roff) & 255) * 256) : blo_; \
            _Pragma("unroll") for (int db = 0; db < 8; ++db) { \
                dst[2 * db] = __builtin_amdgcn_ds_read_tr16_b64_v4i16((LAS s16x4*)(Vi + blo_ + vL[db])); \
                dst[2 * db + 1] = __builtin_amdgcn_ds_read_tr16_b64_v4i16((LAS s16x4*)(Vi + bhi_ + vL[db])); } } while (0)
        LDV16(va[0], 0);
#pragma unroll
        for (int s = 0; s < 5; ++s) {
            if (s + 1 < 5) LDV16(va[(s + 1) & 1], s + 1);
            __builtin_amdgcn_sched_barrier(0);
            const bf16x8 Pf = pack8(S[2 * s], (2 * s + 1 < 9) ? S[2 * s + 1] : (f32x4){0.f, 0.f, 0.f, 0.f});
#pragma unroll
            for (int db = 0; db < 8; ++db) if (!(AV & 4)) O[db] = MFMA16(__builtin_shufflevector(va[s & 1][2 * db], va[s & 1][2 * db + 1], 0, 1, 2, 3, 4, 5, 6, 7), Pf, O[db]);
            __builtin_amdgcn_sched_barrier(0);
        }
#undef LDV16
        const float inv = 1.f / den;
        { LAS unsigned char* st = lds + 131072 + 4096 + wave * 2048;
          const size_t qrow_s = (size_t)(s0 + res) + (size_t)(mq0 + 16 * wave + (lane >> 2)) * d;
          bf16* op = (bf16*)(a.ws + (AV ? WS_QKVN : WS_ATTP)) + ((size_t)br * TG + qrow_s) * 1024 + h * HD + (lane & 3) * 16;
#pragma unroll
          for (int hf = 0; hf < 2; ++hf) { if (AV & 32) { asm volatile("" :: "v"(O[4 * hf]), "v"(O[4 * hf + 1]), "v"(O[4 * hf + 2]), "v"(O[4 * hf + 3])); continue; }
#pragma unroll
              for (int db = 0; db < 4; ++db) { const f32x4 o = O[4 * hf + db]; *(LAS v2u*)(st + ql * 128 + (16 * db + 4 * g4) * 2) = (v2u){cvtpk(o[0] * inv, o[1] * inv), cvtpk(o[2] * inv, o[3] * inv)}; }
              const v4u w0 = *(const LAS v4u*)(st + (lane >> 2) * 128 + (lane & 3) * 32), w1 = *(const LAS v4u*)(st + (lane >> 2) * 128 + (lane & 3) * 32 + 16);
              *(v4u*)(op + 64 * hf) = w0; *(v4u*)(op + 64 * hf + 8) = w1;
          } }
        { float* ml = (float*)(a.ws + (AV ? WS_GATES : WS_ATTML)) + (((size_t)br * TG + qrow) * 8 + h) * 2; *(f32x2v*)ml = (f32x2v){mx, den}; }
        tile = ntile; if (sec) { nxt = nn2; nxtq = nn2q; }
    }
#undef ATT_ISSUE_KQ
#undef ATT_IMG
#undef ATT_FETCH
    asm volatile("s_waitcnt vmcnt(0) lgkmcnt(0)" ::: "memory"); __builtin_amdgcn_s_barrier(); asm volatile("" ::: "memory");
}
DI void ph_attn_merge(CArgs& a, int l) {
    const int lane = otid() & 63, wave = __builtin_amdgcn_readfirstlane(otid() >> 6), gw = obid() * NWAVES + wave, NGW = gridDim.x * NWAVES;
    const bf16* AP = (const bf16*)(a.ws + WS_ATTP); const float* ML = (const float*)(a.ws + WS_ATTML); bf16* MIX = (bf16*)(a.ws + WS_MIX);
    const float* gain = a.in[8] + (size_t)l * HD + (lane & 7) * 16;
    float gn[16];
#pragma unroll
    for (int i = 0; i < 16; ++i) gn[i] = gain[i];
    const int h = lane >> 3;
    for (int r0 = gw; r0 < TG; r0 += 2 * NGW) {
        v4u pw[2][3][2]; f32x2v mlv[2][3];
#pragma unroll
        for (int rr = 0; rr < 2; ++rr) { const int r = r0 + rr * NGW;
#pragma unroll
            for (int b = 0; b < 3; ++b) { mlv[rr][b] = *(const f32x2v*)(ML + (((size_t)b * TG + r) * 8 + h) * 2);
                pw[rr][b][0] = *(const v4u*)(AP + ((size_t)b * TG + r) * 1024 + lane * 16); pw[rr][b][1] = *(const v4u*)(AP + ((size_t)b * TG + r) * 1024 + lane * 16 + 8); } }
#pragma unroll
        for (int rr = 0; rr < 2; ++rr) { const int r = r0 + rr * NGW;
            const float ma = fmaxf(mlv[rr][0].x, fmaxf(mlv[rr][1].x, mlv[rr][2].x));
            float w[3], ws = 0.f;
#pragma unroll
            for (int b = 0; b < 3; ++b) { w[b] = __expf(mlv[rr][b].x - ma) * mlv[rr][b].y; ws += w[b]; }
            const float inv = 1.f / ws;
            float o[16];
#pragma unroll
            for (int i = 0; i < 16; ++i) o[i] = 0.f;
#pragma unroll
            for (int b = 0; b < 3; ++b) { const float wb = w[b] * inv;
#pragma unroll
                for (int hf = 0; hf < 2; ++hf) { const v4u f = pw[rr][b][hf]; const unsigned fw[4] = {f.x, f.y, f.z, f.w};
#pragma unroll
                    for (int k = 0; k < 4; ++k) { o[hf * 8 + 2 * k] += wb * bflo(fw[k]); o[hf * 8 + 2 * k + 1] += wb * bfhi(fw[k]); } } }
            float ss = 0.f;
#pragma unroll
            for (int i = 0; i < 16; ++i) ss += o[i] * o[i];
            ss += shx(ss, 1); ss += shx(ss, 2); ss += shx(ss, 4);
            const float rinv = rsqrtf(ss * (1.f / HD) + EPS);
            unsigned wv[8];
#pragma unroll
            for (int k = 0; k < 8; ++k) wv[k] = pk2(o[2 * k] * rinv * gn[2 * k], o[2 * k + 1] * rinv * gn[2 * k + 1]);
            *(v4u*)(MIX + (size_t)r * DM + lane * 16) = (v4u){wv[0], wv[1], wv[2], wv[3]};
            *(v4u*)(MIX + (size_t)r * DM + lane * 16 + 8) = (v4u){wv[4], wv[5], wv[6], wv[7]};
        }
    }
}
DI void ph_dn_prep(CArgs& a, int l) {
    const int lane = otid() & 63, wave = __builtin_amdgcn_readfirstlane(otid() >> 6), gw = obid() * NWAVES + wave, NGW = gridDim.x * NWAVES;
    const bf16* RAW = (const bf16*)(a.ws + WS_QKVD); bf16* QN = (bf16*)(a.ws + WS_QKVN);
    const float* cw = a.in[5] + (size_t)l * 3 * 3072;
    constexpr int RS = 32, NSTRIP = TG / RS;
    for (int task = gw; task < NSTRIP * 6; task += NGW) {
        const int strip = task / 6, cgp = task % 6, c0 = cgp * 512 + lane * 8, which = c0 >> 10, r0 = strip * RS;
        int s0, L; seq_of(r0, s0, L);
        float w0[8], w1[8], w2[8];
#pragma unroll
        for (int i = 0; i < 8; ++i) { w0[i] = cw[c0 + i]; w1[i] = cw[3072 + c0 + i]; w2[i] = cw[6144 + c0 + i]; }
        const float qs = which == 0 ? oc(0.08838834764831845f) : 1.f;
        v4u prev = (v4u){0u, 0u, 0u, 0u}, cur;
        if (r0 > s0) prev = *(const v4u*)(RAW + (size_t)(r0 - 1) * 3072 + c0);
        cur = *(const v4u*)(RAW + (size_t)r0 * 3072 + c0);
        for (int rb = 0; rb < RS; rb += 8) {
            v4u nx[8];
#pragma unroll
            for (int k = 0; k < 8; ++k) { const int r = r0 + rb + k + 1; nx[k] = (r < s0 + L) ? *(const v4u*)(RAW + (size_t)r * 3072 + c0) : (v4u){0u, 0u, 0u, 0u}; }
#pragma unroll
            for (int k = 0; k < 8; ++k) {
                const unsigned a0[4] = {prev.x, prev.y, prev.z, prev.w}, a1[4] = {cur.x, cur.y, cur.z, cur.w}, a2[4] = {nx[k].x, nx[k].y, nx[k].z, nx[k].w};
                float y[8]; float ss = 0.f;
#pragma unroll
                for (int j = 0; j < 4; ++j) {
                    y[2 * j] = siluf(w0[2 * j] * bflo(a0[j]) + w1[2 * j] * bflo(a1[j]) + w2[2 * j] * bflo(a2[j]));
                    y[2 * j + 1] = siluf(w0[2 * j + 1] * bfhi(a0[j]) + w1[2 * j + 1] * bfhi(a1[j]) + w2[2 * j + 1] * bfhi(a2[j]));
                    ss += y[2 * j] * y[2 * j] + y[2 * j + 1] * y[2 * j + 1];
                }
                float sc = 1.f;
                if (which < 2) { ss += row_ror<8>(ss); ss += row_ror<4>(ss); ss += row_ror<2>(ss); ss += row_ror<1>(ss); sc = rsqrtf(ss + EPS) * qs; }
                *(v4u*)(QN + (size_t)(r0 + rb + k) * 3072 + c0) = (v4u){cvtpk(y[0] * sc, y[1] * sc), cvtpk(y[2] * sc, y[3] * sc), cvtpk(y[4] * sc, y[5] * sc), cvtpk(y[6] * sc, y[7] * sc)};
                prev = cur; cur = nx[k];
            }
        }
    }
    const float* GT = (const float*)(a.ws + WS_GATES); float* BG = (float*)(a.ws + WS_BG);
    const float* alog = a.in[6] + l * 16; const float* dtb = a.in[7] + l * 16;
    for (int i = obid() * NTHR + otid(); i < TG * 32; i += gridDim.x * NTHR) {
        const int c = i & 31; const float x = GT[i]; float y;
        if (c < 16) y = 1.f / (1.f + __expf(-x));
        else { const float t = x + dtb[c - 16]; const float sp = t > 20.f ? t : __builtin_amdgcn_logf(1.f + __expf(t)) * oc(0.69314718f); y = -__expf(alog[c - 16]) * sp; }
        BG[i] = y;
    }
}
DI void ph_dn_scan_simple(CArgs& a, LAS unsigned char* lds) {
    const int t = otid(), c = t & 127, kg = __builtin_amdgcn_readfirstlane(t >> 7);
    LAS float* kq = (LAS float*)lds;
    LAS float* red = (LAS float*)(lds + 2048);
    LAS float* red2 = (LAS float*)(lds + 2048 + 4096);
    const bf16* QN = (const bf16*)(a.ws + WS_QKVN); const float* BG = (const float*)(a.ws + WS_BG);
    for (int chain = obid(); chain < 96; chain += gridDim.x) {
        const int seq = chain >> 4, h = (chain >> 1) & 7, dir = chain & 1;
        const int s0 = seq < 4 ? seq * 4096 : 16384 + (seq - 4) * 8192, L = seq < 4 ? 4096 : 8192;
        bf16* O = (bf16*)(a.ws + (dir ? WS_OB : WS_OF));
        float S[32];
#pragma unroll
        for (int i = 0; i < 32; ++i) S[i] = 0.f;
        int row = s0 + (dir ? L - 1 : 0);
        float kq_r = 0.f, v_r, g_r, b_r;
        if (t < 256) kq_r = bf2f(QN[(size_t)row * 3072 + (t < 128 ? 1024 + h * HD + t : h * HD + (t - 128))]);
        v_r = bf2f(QN[(size_t)row * 3072 + 2048 + h * HD + c]); b_r = BG[(size_t)row * 32 + dir * 8 + h]; g_r = BG[(size_t)row * 32 + 16 + dir * 8 + h];
        int prow = row;
        for (int i = 0; i < L; ++i) {
            const int buf = i & 1; const int crow = row;
            if (t < 256) kq[buf * 256 + t] = kq_r;
            const float v = v_r, eg = __expf(g_r), beta = b_r;
            if (i + 1 < L) { row = s0 + (dir ? L - 2 - i : i + 1);
                if (t < 256) kq_r = bf2f(QN[(size_t)row * 3072 + (t < 128 ? 1024 + h * HD + t : h * HD + (t - 128))]);
                v_r = bf2f(QN[(size_t)row * 3072 + 2048 + h * HD + c]); b_r = BG[(size_t)row * 32 + dir * 8 + h]; g_r = BG[(size_t)row * 32 + 16 + dir * 8 + h]; }
            __syncthreads();
            if (i > 0 && kg == 0) { const LAS float* rr = red2 + (buf ^ 1) * 512; O[(size_t)prow * 1024 + h * HD + c] = (bf16)f2bf(rr[c] + rr[128 + c] + rr[256 + c] + rr[384 + c]); }
            const LAS float* kk = kq + buf * 256 + kg * 32; const LAS float* qq = kq + buf * 256 + 128 + kg * 32;
            float part = 0.f;
#pragma unroll
            for (int j = 0; j < 32; ++j) { S[j] *= eg; part += kk[j] * S[j]; }
            red[buf * 512 + kg * 128 + c] = part;
            __syncthreads();
            const LAS float* rr = red + buf * 512; const float tot = rr[c] + rr[128 + c] + rr[256 + c] + rr[384 + c];
            const float vn = beta * (v - tot); float op = 0.f;
#pragma unroll
            for (int j = 0; j < 32; ++j) { S[j] += kk[j] * vn; op += qq[j] * S[j]; }
            red2[buf * 512 + kg * 128 + c] = op;
            prow = crow;
        }
        __syncthreads();
        if (kg == 0) { const LAS float* rr = red2 + ((L - 1) & 1) * 512; O[(size_t)prow * 1024 + h * HD + c] = (bf16)f2bf(rr[c] + rr[128 + c] + rr[256 + c] + rr[384 + c]); }
        __syncthreads();
    }
}

constexpr int NITEM = (TG / 64) * NH * 2;
constexpr int TQ_ITEM = 3072;
__host__ __device__ constexpr int tri_off(int i) { return i == 0 ? 0 : 4 * (2 * ((i - 1) >> 2) * (((i - 1) >> 2) + 1) + ((i - 1) & 3) * (((i - 1) >> 2) + 1)); }
constexpr int SA_WAVE_LDS = 9216 + 4096 + 1024;
static_assert(8 * SA_WAVE_LDS <= MISC_OFF, "stage A LDS map");
DI f32x4 mm4(f32x4 acc, const f32x4 aop, const f32x4 x) {
#pragma unroll
    for (int e = 0; e < 4; ++e) acc = __builtin_amdgcn_mfma_f32_16x16x4f32(aop[e], x[e], acc, 0, 0, 0);
    return acc; }
DI void ph_dn_stageA(CArgs& a, LAS unsigned char* lds, int g) {
    const int lane = otid() & 63, wave = __builtin_amdgcn_readfirstlane(otid() >> 6), gw = obid() * NWAVES + wave, NGW = gridDim.x * NWAVES;
    LAS unsigned char* wl = lds + wave * SA_WAVE_LDS;
    LAS float* Ap = (LAS float*)wl; LAS unsigned short* stg = (LAS unsigned short*)wl; LAS float* Sb = (LAS float*)(wl + 9216);
    LAS float* sgcF = (LAS float*)(wl + 9216 + 4096); LAS float* sbtF = sgcF + 64; LAS float* sgcB = sgcF + 128; LAS float* sbtB = sgcF + 192;
    const bf16* QN = (const bf16*)(a.ws + WS_QKVN); const float* BG = (const float*)(a.ws + WS_BG);
    bf16* TQ = (bf16*)(a.ws + ws_h(g)); float* SC = (float*)(a.ws + WS_SC);
    for (int pair = gw; pair < NITEM / 2; pair += NGW) {
        const int h = pair & 7, row0 = (pair >> 3) * 64, itemF = pair * 2, itemB = pair * 2 + 1;
        int lo_ = lane; asm volatile("" : "+v"(lo_));
        const int n = lo_ & 15, g4 = lo_ >> 4;
        { const int rf = row0 + lane, rb = row0 + 63 - lane;
          const float gvF = BG[(size_t)rf * 32 + 16 + h], btF = BG[(size_t)rf * 32 + h], gvB = BG[(size_t)rb * 32 + 24 + h], btB = BG[(size_t)rb * 32 + 8 + h];
          float gcF = gvF, gcB = gvB;
#pragma unroll
          for (int off = 1; off < 64; off <<= 1) {
              const float tF = __builtin_bit_cast(float, __builtin_amdgcn_ds_bpermute(((lane - off) & 63) << 2, __builtin_bit_cast(int, gcF)));
              const float tB = __builtin_bit_cast(float, __builtin_amdgcn_ds_bpermute(((lane - off) & 63) << 2, __builtin_bit_cast(int, gcB)));
              if (lane >= off) { gcF += tF; gcB += tB; } }
          const float glF = __builtin_bit_cast(float, __builtin_amdgcn_readlane(__builtin_bit_cast(int, gcF), 63)), glB = __builtin_bit_cast(float, __builtin_amdgcn_readlane(__builtin_bit_cast(int, gcB), 63));
          sgcF[lane] = gcF; sbtF[lane] = btF; sgcB[lane] = gcB; sbtB[lane] = btB;
          float* scF = SC + (size_t)itemF * 192; scF[lane] = __expf(gcF); scF[64 + lane] = btF; scF[128 + lane] = __expf(glF - gcF);
          float* scB = SC + (size_t)itemB * 192; scB[lane] = __expf(gcB); scB[64 + lane] = btB; scB[128 + lane] = __expf(glB - gcB); }
        bf16x8 kf[4][4];
#pragma unroll
        for (int blk = 0; blk < 4; ++blk) { const int row = row0 + 16 * blk + n;
#pragma unroll
            for (int s = 0; s < 4; ++s) kf[blk][s] = *(const bf16x8*)(QN + (size_t)row * 3072 + 1024 + h * HD + 32 * s + 8 * g4); }
#pragma unroll
        for (int dirb = 0; dirb < 2; ++dirb) {
#pragma unroll
            for (int mb = 0; mb < 4; ++mb) {
                const int rb0 = 16 * mb + 4 * g4;
                const f32x4 gFr = *(const LAS f32x4*)(sgcF + rb0), bFr = *(const LAS f32x4*)(sbtF + rb0), gBr = *(const LAS f32x4*)(sgcB + 60 - rb0);
#pragma unroll
                for (int nb = 0; nb <= mb; ++nb) {
                    f32x4 c = (f32x4){0.f, 0.f, 0.f, 0.f};
#pragma unroll
                    for (int s = 0; s < 4; ++s) c = MFMA16(kf[mb][s], kf[nb][s], c);
                    const int cc = 16 * nb + n, ib = 63 - cc; const float gFc = sgcF[cc], gBc = sgcB[ib], bBc = sbtB[ib];
                    const int tob = tri_off(ib);
#pragma unroll
                    for (int i = 0; i < 4; ++i) { const int r = rb0 + i;
                        if (r > cc) { if (dirb == 0) Ap[tri_off(r) + cc] = c[i] * __expf(fminf(gFr[i] - gFc, 0.f)) * bFr[i];
                                      else Ap[tob + (63 - r)] = c[i] * __expf(fminf(gBc - gBr[3 - i], 0.f)) * bBc; } }
                }
            }
            int toA[4];
#pragma unroll
            for (int bi = 0; bi < 4; ++bi) toA[bi] = tri_off(16 * bi + n) + 4 * g4;
#define SA_LDA(bi, bk) (*(const LAS f32x4*)(Ap + toA[bi] + 16 * (bk)))
#define SA_STS(j, X) do { _Pragma("unroll") for (int e = 0; e < 4; ++e) Sb[256 * (j) + (4 * g4 + e) * 16 + n] = (X)[e]; } while (0)
#define SA_LDS(j) (*(const LAS f32x4*)(Sb + 256 * (j) + n * 16 + 4 * g4))
            f32x4 T[4][4];
            f32x4 Nop[4], Nr[4], X[4], P[4];
#pragma unroll
            for (int j = 0; j < 4; ++j) {
                const f32x4 raw = SA_LDA(j, j);
#pragma unroll
                for (int e = 0; e < 4; ++e) { Nop[j][e] = (4 * g4 + e < n) ? raw[e] : 0.f;
                    Nr[j][e] = (n < 4 * g4 + e) ? Ap[tri_off(16 * j + 4 * g4 + e) + 16 * j + n] : 0.f;
                    X[j][e] = ((n == 4 * g4 + e) ? 1.f : 0.f) - Nr[j][e]; }
                P[j] = mm4((f32x4){0.f, 0.f, 0.f, 0.f}, Nop[j], Nr[j]);
                SA_STS(j, P[j]);
            }
#pragma unroll
            for (int st = 0; st < 3; ++st)
#pragma unroll
                for (int j = 0; j < 4; ++j) {
                    const f32x4 pop = SA_LDS(j);
                    X[j] = mm4(X[j], pop, X[j]);
                    if (st < 2) { P[j] = mm4((f32x4){0.f, 0.f, 0.f, 0.f}, pop, P[j]); SA_STS(j, P[j]); }
                    else SA_STS(j, X[j]);
                }
#pragma unroll
            for (int j = 0; j < 4; ++j) T[j][j] = X[j];
#pragma unroll
            for (int d = 1; d < 4; ++d)
#pragma unroll
                for (int j = 0; j + d < 4; ++j) { const int bi = j + d;
                    f32x4 W = (f32x4){0.f, 0.f, 0.f, 0.f};
#pragma unroll
                    for (int k = j; k < bi; ++k) W = mm4(W, SA_LDA(bi, k), T[k][j]);
                    const f32x4 R = mm4((f32x4){0.f, 0.f, 0.f, 0.f}, SA_LDS(bi), W);
                    T[bi][j] = -R; }
#undef SA_LDA
#undef SA_STS
#undef SA_LDS
            asm volatile("" ::: "memory");
#pragma unroll
            for (int bi = 0; bi < 4; ++bi)
#pragma unroll
                for (int bj = 0; bj < 4; ++bj)
#pragma unroll
                    for (int e = 0; e < 4; ++e) stg[(16 * bi + 4 * g4 + e) * 72 + 16 * bj + n] = (bj <= bi) ? (unsigned short)f2bf(T[bi][bj][e]) : (unsigned short)0;
            const int item = dirb ? itemB : itemF;
#pragma unroll
            for (int it = 0; it < 6; ++it) { const int pc = it * 64 + lane, r = pc < 128 ? (pc >> 2) : 32 + ((pc - 128) >> 3), ch = pc < 128 ? (pc & 3) : ((pc - 128) & 7);
                const v4u v = *(const LAS v4u*)(wl + r * 144 + ch * 16); *(v4u*)(TQ + (size_t)item * TQ_ITEM + pc * 8) = v; }
            asm volatile("" ::: "memory");
        }
        {
            f32x4 pq[4][4];
#pragma unroll
            for (int half = 0; half < 2; ++half) {
                bf16x8 qf2[2][4];
#pragma unroll
                for (int b2 = 0; b2 < 2; ++b2) { const int row = row0 + 16 * (2 * half + b2) + n;
#pragma unroll
                    for (int s = 0; s < 4; ++s) qf2[b2][s] = *(const bf16x8*)(QN + (size_t)row * 3072 + h * HD + 32 * s + 8 * g4); }
#pragma unroll
                for (int b2 = 0; b2 < 2; ++b2)
#pragma unroll
                    for (int nb = 0; nb < 4; ++nb) { f32x4 c = (f32x4){0.f, 0.f, 0.f, 0.f};
#pragma unroll
                        for (int s = 0; s < 4; ++s) c = MFMA16(qf2[b2][s], kf[nb][s], c);
                        pq[2 * half + b2][nb] = c; }
                asm volatile("" ::: "memory");
            }
#pragma unroll
            for (int dirb = 0; dirb < 2; ++dirb) {
#pragma unroll
                for (int mb = 0; mb < 4; ++mb) {
                    const int rb0 = 16 * mb + 4 * g4;
                    const f32x4 gFr = *(const LAS f32x4*)(sgcF + rb0), gBr = *(const LAS f32x4*)(sgcB + 60 - rb0);
#pragma unroll
                    for (int nb = 0; nb < 4; ++nb) {
                        const int cc = 16 * nb + n; const float gFc = sgcF[cc], gBc = sgcB[63 - cc];
#pragma unroll
                        for (int i = 0; i < 4; ++i) { const int r = rb0 + i;
                            if (dirb == 0) stg[r * 72 + cc] = (unsigned short)f2bf((nb <= mb && r >= cc) ? pq[mb][nb][i] * __expf(fminf(gFr[i] - gFc, 0.f)) : 0.f);
                            else stg[(63 - r) * 72 + (63 - cc)] = (unsigned short)f2bf((nb >= mb && r <= cc) ? pq[mb][nb][i] * __expf(fminf(gBr[3 - i] - gBc, 0.f)) : 0.f); }
                    }
                }
                const int item = dirb ? itemB : itemF;
#pragma unroll
                for (int it = 0; it < 6; ++it) { const int pc = it * 64 + lane, r = pc < 128 ? (pc >> 2) : 32 + ((pc - 128) >> 3), ch = pc < 128 ? (pc & 3) : ((pc - 128) & 7);
                    const v4u v = *(const LAS v4u*)(wl + r * 144 + ch * 16); *(v4u*)(TQ + (size_t)(NITEM + item) * TQ_ITEM + pc * 8) = v; }
                asm volatile("" ::: "memory");
            }
        }
    }
}
DI bf16x8 ld2x8(const LAS unsigned char* p0, const LAS unsigned char* p1) { const v2u lo = *(const LAS v2u*)p0, hi = *(const LAS v2u*)p1; return __builtin_bit_cast(bf16x8, (v4u){lo.x, lo.y, hi.x, hi.y}); }
DI bf16x8 pack16(const f32x16& x, int s) { v4u p; p.x = cvtpk(x[8 * s], x[8 * s + 1]); p.y = cvtpk(x[8 * s + 2], x[8 * s + 3]); p.z = cvtpk(x[8 * s + 4], x[8 * s + 5]); p.w = cvtpk(x[8 * s + 6], x[8 * s + 7]); return __builtin_bit_cast(bf16x8, p); }
DI void st2x8(LAS unsigned char* p, const v4u v) { *(LAS v2u*)p = (v2u){v.x, v.y}; *(LAS v2u*)(p + 8) = (v2u){v.z, v.w}; }
DI void stperm(LAS unsigned char* rowp, int c, const v4u v) { LAS unsigned char* p = rowp + (16 * (c >> 1) + 4 * (c & 1)) * 2; *(LAS v2u*)p = (v2u){v.x, v.y}; *(LAS v2u*)(p + 16) = (v2u){v.z, v.w}; }
#define SBAR() do { asm volatile("s_waitcnt lgkmcnt(0)" ::: "memory"); __builtin_amdgcn_s_barrier(); asm volatile("" ::: "memory"); } while (0)
#define MULS(x, y) ((x) * (y))
template <int VAR> DI void ph_dn_scan2(CArgs& a, LAS unsigned char* lds, int g) {
    const int t = otid(), lane = t & 63, wave = __builtin_amdgcn_readfirstlane(t >> 6), r = lane & 31, h5 = lane >> 5, i16 = lane & 15, q4 = i16 >> 2, p4 = i16 & 3, blk = (lane >> 4) & 1;
    constexpr int KP = 272, TP = 144, OP = 80;
    constexpr int O_K = 0, O_Q = 64 * KP, O_V = 2 * 64 * KP, O_T = 3 * 64 * KP, O_QK = O_T + 64 * TP, O_SC = O_QK + 64 * TP, SETB = O_SC + 768;
    static_assert(2 * SETB + 4 * 64 * OP <= MISC_OFF, "scan LDS map");
    for (int chain = obid(); chain < 192; chain += gridDim.x) {
        const int seq = chain < 64 ? 8 + (chain >> 4) : (chain - 64) >> 4, h = (chain >> 1) & 7, dir = chain & 1;
        const int s0 = seq < 8 ? seq * 4096 : 32768 + (seq - 8) * 8192, L = seq < 8 ? 4096 : 8192, NC = L >> 6;
        if (wave >= 4) {
            int tL_ = t; asm volatile("" : "+v"(tL_)); const int tl = tL_ & 255;
            const bf16* QN = (const bf16*)(a.ws + WS_QKVN); const bf16* TQ = (const bf16*)(a.ws + ws_h(g)); const float* SC = (const float*)(a.ws + WS_SC);
            v4u rk[4], rq[4], rv[4], rt[2], rqk[2]; float rs = 0.f;
            int poff[4];
#pragma unroll
            for (int u = 0; u < 4; ++u) { const int idx = tl + 256 * u, ip = idx >> 4, ch = idx & 15; poff[u] = (dir ? 63 - ip : ip) * 3072 + ch * 8; }
#define DN_ISSUE(nn) do { const int r0_ = s0 + 64 * (dir ? NC - 1 - (nn) : (nn)); const size_t it_ = (size_t)(((r0_ >> 6) * 8 + h) * 2 + dir); \
            const bf16* qb_ = QN + (size_t)r0_ * 3072 + h * HD; const bf16* tb_ = TQ + it_ * TQ_ITEM; \
            _Pragma("unroll") for (int u = 0; u < 4; ++u) { rq[u] = *(const v4u*)(qb_ + poff[u]); rk[u] = *(const v4u*)(qb_ + 1024 + poff[u]); rv[u] = *(const v4u*)(qb_ + 2048 + poff[u]); } \
            _Pragma("unroll") for (int u = 0; u < 2; ++u) { const int pc = (u == 0 || tl < 128) ? tl + 256 * u : tl;     \
                rt[u] = *(const v4u*)(tb_ + pc * 8); rqk[u] = *(const v4u*)(tb_ + (size_t)NITEM * TQ_ITEM + pc * 8); } \
            if (tl < 192) rs = SC[it_ * 192 + tl]; } while (0)
#define DN_WRITE(set) do { LAS unsigned char* sb_ = lds + (set) * SETB; \
            _Pragma("unroll") for (int u = 0; u < 4; ++u) { const int idx = tl + 256 * u, ip = idx >> 4, ch = idx & 15; \
                stperm(sb_ + O_K + ip * KP, ch, rk[u]); stperm(sb_ + O_Q + ip * KP, ch, rq[u]); *(LAS v4u*)(sb_ + O_V + ip * KP + ch * 16) = rv[u]; } \
            _Pragma("unroll") for (int u = 0; u < 2; ++u) { if (u == 0 || tl < 128) { const int pc = tl + 256 * u, r_ = pc < 128 ? (pc >> 2) : 32 + ((pc - 128) >> 3), ch_ = pc < 128 ? (pc & 3) : ((pc - 128) & 7); \
                stperm(sb_ + O_T + r_ * TP, ch_, rt[u]); stperm(sb_ + O_QK + r_ * TP, ch_, rqk[u]); } } \
            if (tl < 192) ((LAS float*)(sb_ + O_SC))[tl] = rs; } while (0)
            if (VAR != 4) { DN_ISSUE(0); DN_WRITE(0); if (NC > 1) DN_ISSUE(1); }
            SBAR();
            for (int nn = 0; nn < NC; ++nn) {
                if (VAR != 4 && nn + 1 < NC) { DN_WRITE((nn + 1) & 1); if (nn + 2 < NC) DN_ISSUE(nn + 2); }
                SBAR();
            }
#undef DN_ISSUE
#undef DN_WRITE
        } else {
            int tc_ = t; asm volatile("" : "+v"(tc_));
            const int lane = tc_ & 63, r = lane & 31, h5 = lane >> 5, i16 = lane & 15, q4 = i16 >> 2, p4 = i16 & 3, blk = (lane >> 4) & 1;
            bf16* O = (bf16*)(a.ws + (VAR ? (dir ? WS_QKVD + 64 * MiB : WS_QKVD) : (dir ? WS_OB : WS_OF)));
            LAS unsigned char* Ow = lds + 2 * SETB + wave * (64 * OP);
            f32x16 S[4];
#pragma unroll
            for (int kb = 0; kb < 4; ++kb)
#pragma unroll
                for (int i = 0; i < 16; ++i) S[kb][i] = 0.f;
            SBAR();
            for (int nn = 0; nn < NC; ++nn) {
                const LAS unsigned char* sb = lds + (nn & 1) * SETB;
                const LAS unsigned char* Kc = sb + O_K; const LAS unsigned char* Qc = sb + O_Q; const LAS unsigned char* Vt = sb + O_V;
                const LAS unsigned char* Tc = sb + O_T; const LAS unsigned char* QKc = sb + O_QK; const LAS float* sc = (const LAS float*)(sb + O_SC);
                if (VAR != 2) {
                const float eglast = sc[63];
#define LDA(base, pitch, row, col16) (*(const LAS bf16x8*)((base) + (row) * (pitch) + ((col16) * 16 + 8 * h5) * 2))
                f32x16 P[2], Qs[2];
#pragma unroll
                for (int mb = 0; mb < 2; ++mb)
#pragma unroll
                    for (int i = 0; i < 16; ++i) { P[mb][i] = 0.f; Qs[mb][i] = 0.f; }
                bf16x8 fa[2][4];
#define LDG(dst, j_) do { dst[0] = LDA(Kc, KP, r, (j_)); dst[1] = LDA(Kc, KP, 32 + r, (j_)); dst[2] = LDA(Qc, KP, r, (j_)); dst[3] = LDA(Qc, KP, 32 + r, (j_)); } while (0)
                LDG(fa[0], 0);
                bf16x8 tf[6];
#pragma unroll
                for (int j = 0; j < 8; ++j) {
                    if (j + 1 < 8) LDG(fa[(j + 1) & 1], j + 1);
                    else { tf[0] = LDA(Tc, TP, r, 0); tf[1] = LDA(Tc, TP, r, 1); tf[2] = LDA(Tc, TP, 32 + r, 0); tf[3] = LDA(Tc, TP, 32 + r, 1); tf[4] = LDA(Tc, TP, 32 + r, 2); tf[5] = LDA(Tc, TP, 32 + r, 3); }
                    __builtin_amdgcn_sched_barrier(0);
                    const bf16x8 Bf = pack16(S[j >> 1], j & 1);
                    if (VAR != 3) { P[0] = MFMA32(fa[j & 1][0], Bf, P[0]); P[1] = MFMA32(fa[j & 1][1], Bf, P[1]); Qs[0] = MFMA32(Bf, fa[j & 1][2], Qs[0]); Qs[1] = MFMA32(Bf, fa[j & 1][3], Qs[1]); }
                    __builtin_amdgcn_sched_barrier(0);
                }
#undef LDG
#pragma unroll
                for (int mb = 0; mb < 2; ++mb)
#pragma unroll
                    for (int gi = 0; gi < 4; ++gi) {
                        const int tb = 32 * mb + 8 * gi + 4 * h5;
                        const s16x4 v4 = __builtin_amdgcn_ds_read_tr16_b64_v4i16((LAS s16x4*)(Vt + (tb + q4) * KP + (32 * wave + 16 * blk + 4 * p4) * 2));
                        const f32x4 egc4 = *(const LAS f32x4*)(sc + tb), bt4 = *(const LAS f32x4*)(sc + 64 + tb);
#pragma unroll
                        for (int ii = 0; ii < 4; ++ii) P[mb][4 * gi + ii] = MULS(bt4[ii], bf2f((unsigned)(unsigned short)v4[ii]) - MULS(egc4[ii], P[mb][4 * gi + ii]));
                    }
                bf16x8 qf6[6];
                qf6[0] = LDA(QKc, TP, r, 0); qf6[1] = LDA(QKc, TP, r, 1); qf6[2] = LDA(QKc, TP, 32 + r, 0); qf6[3] = LDA(QKc, TP, 32 + r, 1); qf6[4] = LDA(QKc, TP, 32 + r, 2); qf6[5] = LDA(QKc, TP, 32 + r, 3);
                __builtin_amdgcn_sched_barrier(0);
                f32x16 Vn[2];
#pragma unroll
                for (int mb = 0; mb < 2; ++mb)
#pragma unroll
                    for (int i = 0; i < 16; ++i) Vn[mb][i] = 0.f;
                { const bf16x8 R00 = pack16(P[0], 0), R01 = pack16(P[0], 1), R10 = pack16(P[1], 0), R11 = pack16(P[1], 1);
                  Vn[0] = MFMA32(tf[0], R00, Vn[0]); Vn[1] = MFMA32(tf[2], R00, Vn[1]); Vn[0] = MFMA32(tf[1], R01, Vn[0]); Vn[1] = MFMA32(tf[3], R01, Vn[1]); Vn[1] = MFMA32(tf[4], R10, Vn[1]); Vn[1] = MFMA32(tf[5], R11, Vn[1]); }
                s16x4 kt[2][8];
#define LDKT(dst, kb) do { _Pragma("unroll") for (int mj = 0; mj < 2; ++mj) _Pragma("unroll") for (int s = 0; s < 2; ++s) { \
                    dst[(mj * 2 + s) * 2] = __builtin_amdgcn_ds_read_tr16_b64_v4i16((LAS s16x4*)(Kc + (32 * mj + 16 * s + 4 * h5 + q4) * KP + (32 * (kb) + 16 * blk + pc4) * 2)); \
                    dst[(mj * 2 + s) * 2 + 1] = __builtin_amdgcn_ds_read_tr16_b64_v4i16((LAS s16x4*)(Kc + (32 * mj + 16 * s + 8 + 4 * h5 + q4) * KP + (32 * (kb) + 16 * blk + pc4) * 2)); } } while (0)
                const int pc4 = (p4 == 1 ? 8 : (p4 == 2 ? 4 : 4 * p4));
                if (VAR != 5) {
                { const bf16x8 V00 = pack16(Vn[0], 0), V01 = pack16(Vn[0], 1), V10 = pack16(Vn[1], 0), V11 = pack16(Vn[1], 1);
#pragma unroll
                  for (int mb = 0; mb < 2; ++mb) {
                    const float eg = sc[32 * mb + r];
                    f32x16 o = Qs[mb] * eg;
                    if (mb == 0) { o = MFMA32(V00, qf6[0], o); o = MFMA32(V01, qf6[1], o); }
                    else { o = MFMA32(V00, qf6[2], o); o = MFMA32(V01, qf6[3], o); o = MFMA32(V10, qf6[4], o); o = MFMA32(V11, qf6[5], o); }
#pragma unroll
                    for (int gi = 0; gi < 4; ++gi) { if (VAR != 8) *(LAS v2u*)(Ow + (32 * mb + r) * OP + (8 * gi + 4 * h5) * 2) = (v2u){cvtpk(o[4 * gi], o[4 * gi + 1]), cvtpk(o[4 * gi + 2], o[4 * gi + 3])}; else asm volatile("" :: "v"(o[4 * gi])); }
                  } }
                }
#pragma unroll
                for (int mb = 0; mb < 2; ++mb)
#pragma unroll
                    for (int gi = 0; gi < 4; ++gi) { const f32x4 ekd4 = *(const LAS f32x4*)(sc + 128 + 32 * mb + 8 * gi + 4 * h5);
#pragma unroll
                        for (int ii = 0; ii < 4; ++ii) Vn[mb][4 * gi + ii] = MULS(Vn[mb][4 * gi + ii], ekd4[ii]); }
                if (VAR != 6) LDKT(kt[0], 0);
                { const bf16x8 W[4] = {pack16(Vn[0], 0), pack16(Vn[0], 1), pack16(Vn[1], 0), pack16(Vn[1], 1)};
#pragma unroll
                  for (int kb = 0; kb < 4; ++kb) {
                    if (VAR != 6 && kb + 1 < 4) LDKT(kt[(kb + 1) & 1], kb + 1);
                    __builtin_amdgcn_sched_barrier(0);
#pragma unroll
                    for (int i = 0; i < 16; ++i) S[kb][i] = MULS(S[kb][i], eglast);
#pragma unroll
                    for (int q = 0; q < 4; ++q) if (VAR != 6) S[kb] = MFMA32(__builtin_shufflevector(kt[kb & 1][2 * q], kt[kb & 1][2 * q + 1], 0, 1, 2, 3, 4, 5, 6, 7), W[q], S[kb]);
                    __builtin_amdgcn_sched_barrier(0);
                  } }
#undef LDA
#undef LDKT
                if (VAR != 5 && VAR != 8) {
                { const int row0 = s0 + 64 * (dir ? NC - 1 - nn : nn);
#pragma unroll
                  for (int it = 0; it < 4; ++it) { const int idx = it * 64 + lane, ip = idx >> 2, ch = idx & 3;
                      const v4u ov_ = *(const LAS v4u*)(Ow + ip * OP + ch * 16); if (VAR != 7) *(v4u*)(O + (size_t)(row0 + (dir ? 63 - ip : ip)) * 1024 + h * HD + 32 * wave + ch * 8) = ov_; else asm volatile("" :: "v"(ov_)); } }
                }
                }
                SBAR();
            }
        }
    }
}
DI void ph_dn_merge(CArgs& a, int l) {
    const int lane = otid() & 63, wave = __builtin_amdgcn_readfirstlane(otid() >> 6), gw = obid() * NWAVES + wave, NGW = gridDim.x * NWAVES;
    const bf16* OF = (const bf16*)(a.ws + WS_OF); const bf16* OB = (const bf16*)(a.ws + WS_OB); const bf16* Z = (const bf16*)(a.ws + WS_Z); bf16* MIX = (bf16*)(a.ws + WS_MIX);
    const float* gain = a.in[9] + (size_t)l * HD + (lane & 7) * 16;
    float gn[16];
#pragma unroll
    for (int i = 0; i < 16; ++i) gn[i] = gain[i];
    for (int r = gw; r < TG; r += NGW) {
        float o[16], z[16]; float ss = 0.f;
#pragma unroll
        for (int hf = 0; hf < 2; ++hf) {
            const v4u f = *(const v4u*)(OF + (size_t)r * 1024 + lane * 16 + hf * 8), b = *(const v4u*)(OB + (size_t)r * 1024 + lane * 16 + hf * 8), zz = *(const v4u*)(Z + (size_t)r * 1024 + lane * 16 + hf * 8);
            const unsigned fw[4] = {f.x, f.y, f.z, f.w}, bw[4] = {b.x, b.y, b.z, b.w}, zw[4] = {zz.x, zz.y, zz.z, zz.w};
#pragma unroll
            for (int k = 0; k < 4; ++k) { o[hf * 8 + 2 * k] = bflo(fw[k]) + bflo(bw[k]); o[hf * 8 + 2 * k + 1] = bfhi(fw[k]) + bfhi(bw[k]); z[hf * 8 + 2 * k] = bflo(zw[k]); z[hf * 8 + 2 * k + 1] = bfhi(zw[k]); }
        }
#pragma unroll
        for (int i = 0; i < 16; ++i) ss += o[i] * o[i];
        ss += shx(ss, 1); ss += shx(ss, 2); ss += shx(ss, 4);
        const float rinv = rsqrtf(ss * (1.f / HD) + EPS);
        unsigned w[8];
#pragma unroll
        for (int k = 0; k < 8; ++k) w[k] = pk2(o[2 * k] * rinv * gn[2 * k] * siluf(z[2 * k]), o[2 * k + 1] * rinv * gn[2 * k + 1] * siluf(z[2 * k + 1]));
        *(v4u*)(MIX + (size_t)r * DM + 1024 + lane * 16) = (v4u){w[0], w[1], w[2], w[3]};
        *(v4u*)(MIX + (size_t)r * DM + 1024 + lane * 16 + 8) = (v4u){w[4], w[5], w[6], w[7]};
    }
}
DI void ph_ffn_fix(CArgs& a, int l) {
    const bf16* ED = (const bf16*)(a.ws + WS_EDGE); bf16* GA = (bf16*)(a.ws + WS_GACT);
    const float* cw = a.in[14] + (size_t)l * 3 * NUP; const float* cb = a.in[15] + (size_t)l * NUP;
    constexpr int NCG = DFF / 8, NBLK = TG / 64;
    for (int task = obid() * NTHR + otid(); task < NBLK * NCG * 2; task += gridDim.x * NTHR) {
        const int which = task & 1, t2 = task >> 1, blk = t2 / NCG, c0 = (t2 % NCG) * 8, row0 = blk * 64;
        int s0, L; seq_of(row0, s0, L);
        const v4u zz = (v4u){0u, 0u, 0u, 0u};
        const bf16* e = ED + (size_t)blk * 4 * NUP + c0;
        v4u pg, pu, cg, cu, ng, nu; int row;
        if (which == 0) { row = row0; const bool hp = row0 > s0;
            pg = hp ? *(const v4u*)(e - NUP) : zz; pu = hp ? *(const v4u*)(e - NUP + DFF) : zz;
            cg = *(const v4u*)e; cu = *(const v4u*)(e + DFF); ng = *(const v4u*)(e + NUP); nu = *(const v4u*)(e + NUP + DFF); }
        else { row = row0 + 63; const bool hn = row0 + 64 < s0 + L;
            pg = *(const v4u*)(e + 2 * NUP); pu = *(const v4u*)(e + 2 * NUP + DFF); cg = *(const v4u*)(e + 3 * NUP); cu = *(const v4u*)(e + 3 * NUP + DFF);
            ng = hn ? *(const v4u*)(e + 4 * NUP) : zz; nu = hn ? *(const v4u*)(e + 4 * NUP + DFF) : zz; }
        const unsigned a0[4] = {pg.x, pg.y, pg.z, pg.w}, a1[4] = {cg.x, cg.y, cg.z, cg.w}, a2[4] = {ng.x, ng.y, ng.z, ng.w};
        const unsigned b0[4] = {pu.x, pu.y, pu.z, pu.w}, b1[4] = {cu.x, cu.y, cu.z, cu.w}, b2[4] = {nu.x, nu.y, nu.z, nu.w};
        unsigned w[4];
#pragma unroll
        for (int k = 0; k < 4; ++k) {
            const int c = c0 + 2 * k;
            const float g0 = cw[c] * bflo(a0[k]) + cw[NUP + c] * bflo(a1[k]) + cw[2 * NUP + c] * bflo(a2[k]) + cb[c];
            const float g1 = cw[c + 1] * bfhi(a0[k]) + cw[NUP + c + 1] * bfhi(a1[k]) + cw[2 * NUP + c + 1] * bfhi(a2[k]) + cb[c + 1];
            const float u0 = cw[DFF + c] * bflo(b0[k]) + cw[NUP + DFF + c] * bflo(b1[k]) + cw[2 * NUP + DFF + c] * bflo(b2[k]) + cb[DFF + c];
            const float u1 = cw[DFF + c + 1] * bfhi(b0[k]) + cw[NUP + DFF + c + 1] * bfhi(b1[k]) + cw[2 * NUP + DFF + c + 1] * bfhi(b2[k]) + cb[DFF + c + 1];
            w[k] = cvtpk(siluf(g0) * u0, siluf(g1) * u1);
        }
        *(v4u*)(GA + (size_t)row * DFF + c0) = (v4u){w[0], w[1], w[2], w[3]};
    }
}
#ifndef SCANVAR
#define SCANVAR 0
#endif
#ifndef WGM_IN
#define WGM_IN 4
#endif
#ifndef WGM_OUT
#define WGM_OUT 4
#endif
#ifndef WGM_UP
#define WGM_UP 4
#endif
#ifndef WGM_DN
#define WGM_DN 4
#endif
#ifndef PROBE
#define PROBE 0
#endif
#ifndef ATTVAR
#define ATTVAR 0
#endif
#ifndef DBG_X
#define DBG_X WS_QKVD
#endif
#ifndef DBG_H
#define DBG_H WS_OF
#endif
constexpr int NSTEPS = 1 + DEPTH * (1 + NGRP * 9) + NGRP + ((PROBE & 64) ? DEPTH * NGRP : 0);
__global__ void __launch_bounds__(NTHR, 2) fwd(Args a_unused) {
    extern __shared__ __attribute__((aligned(16))) unsigned char lds_raw[];
    LAS unsigned char* lds = (LAS unsigned char*)lds_raw;
    const int tid = threadIdx.x;
    CArgs* ap0 = (CArgs*)__builtin_amdgcn_kernarg_segment_ptr();
#define a (*({ CArgs* p_ = ap0; asm volatile("" : "+s"(p_)); p_; }))
    volatile LAS unsigned* MISC = (volatile LAS unsigned*)(lds + MISC_OFF);
    for (int u = tid; u < (LDS_BYTES - MISC_OFF) / 4; u += NTHR) ((LAS unsigned*)(lds + MISC_OFF))[u] = 0u;
    __syncthreads();
    unsigned* ctl = (unsigned*)(a.ws + WS_CTL);
    const bool single = (a.s_hi - a.s_lo) > 1;
    XcdBarrier bar; bar.bar = ctl + CW_BAR; bar.x = 0; bar.st = nullptr;
    if (single) bar = xcd_barrier_post(ctl + CW_BAR, MISC + 8);
    int step = 0, L0 = 0, G0 = 0, HF0 = 0;
#define REP(bit) for (int rep_ = 0; rep_ < (((PROBE) >> (bit)) & 1) + 1; ++rep_)
#define RUN(...) do { if (step >= a.s_lo && step < a.s_hi) { int l = L0, g = G0, half = HF0; asm volatile("" : "+s"(l), "+s"(g), "+s"(half)); (void)l; (void)g; (void)half; __builtin_amdgcn_s_waitcnt(0);   __VA_ARGS__; if (step + 1 < a.s_hi) { XcdBarrier b2_ = bar; asm volatile("" : "+s"(b2_.bar), "+s"(b2_.x)); xcd_barrier(b2_); } } ++step; } while (0)
    RUN({ ph_bias(a.in[2], (float*)(a.ws + WS_BIAS));
          { v4u* z = (v4u*)(a.ws + WS_XCH); const unsigned z0 = (unsigned)otid() >> 31; for (int i = obid() * NTHR + otid(); i < (int)(XCH_BYTES / 16); i += gridDim.x * NTHR) z[i] = (v4u){z0, z0, z0, z0}; } });
    for (L0 = 0; L0 < DEPTH; ++L0) {
        RUN(REP(5) ph_weights(a, l, lds));
        for (G0 = 0; G0 < NGRP; ++G0) {
            if (L0 == 0) RUN(REP(4) ph_prenorm(a, l, g));
            RUN(REP(0) { pg8::Gemm gm{(const bf16*)(a.ws + ws_h(g)), (const bf16*)(a.ws + WS_WIN), TG, INP, DM}; pg8::StaticOrder S; S.init(TG, INP, (int)gridDim.x, (int)blockIdx.x, WGM_IN);
                  pg8::EpiRoute E{(bf16*)(a.ws + WS_QKVA), (bf16*)(a.ws + WS_QKVD), (bf16*)(a.ws + WS_Z), (float*)(a.ws + WS_GATES), 3072, 3072, 1024, 12, 24, 28};
                  pg8::gemm_phase<pg8::EpiRoute, pg8::StaticOrder, true, true>(lds, gm, S, E); });
            RUN(REP(1) ph_dn_prep(a, l));
            RUN(REP(2) ph_dn_stageA(a, lds, g));
            RUN(REP(3) { if (rep_ == 0) ph_dn_scan2<0>(a, lds, g); else if (SCANVAR >= 0) ph_dn_scan2<(SCANVAR >= 0 ? SCANVAR : 0)>(a, lds, g); ph_attn2<0>(a, lds, l, g, rep_); });
#if (PROBE & 64)
            RUN(ph_attn2<ATTVAR>(a, lds, l, g, 1));
#endif
            RUN(REP(4) { ph_attn_merge(a, l); ph_dn_merge(a, l); });
            RUN(REP(0) { pg8::Gemm gm{(const bf16*)(a.ws + WS_MIX), (const bf16*)(a.ws + WS_WOUT), TG, DM, DM}; pg8::StaticOrder S; S.init(TG, DM, (int)gridDim.x, (int)blockIdx.x, WGM_OUT);
                  pg8::EpiPM E{(const unsigned long long __attribute__((address_space(4)))*)&a, 11, 12, l * DM, l * DM, (unsigned)WS_H, (unsigned)WS_XCH, (unsigned)(1 + 4 * l),
                                (LAS float*)(lds + RING_BYTES), TG / 256, 0};
                  pg8::gemm_phase<pg8::EpiPM, pg8::StaticOrder, true, true>(lds, gm, S, E); });
            RUN(REP(0) { pg8::Gemm gm{(const bf16*)(a.ws + ws_h(g)), (const bf16*)(a.ws + WS_WUP), TG, NUP, DM}; pg8::StaticOrder S; S.init(TG, NUP, (int)gridDim.x, (int)blockIdx.x, WGM_UP);
                  pg8::EpiGate E{(bf16*)(a.ws + WS_GACT), (bf16*)(a.ws + WS_EDGE), a.in[14] + (size_t)l * 3 * NUP, a.in[15] + (size_t)l * NUP};
                  pg8::gemm_phase<pg8::EpiGate, pg8::StaticOrder, true, true>(lds, gm, S, E); });
            RUN(REP(7) ph_ffn_fix(a, l));
            RUN(REP(0) { pg8::Gemm gm{(const bf16*)(a.ws + WS_GACT), (const bf16*)(a.ws + WS_WDN), TG, DM, DFF}; pg8::StaticOrder S; S.init(TG, DM, (int)gridDim.x, (int)blockIdx.x, WGM_DN);
                  pg8::EpiPM E{(const unsigned long long __attribute__((address_space(4)))*)&a, 17, 3, l * DM, (l + 1 < DEPTH ? l + 1 : l) * DM, (unsigned)WS_H, (unsigned)WS_XCH, (unsigned)(3 + 4 * l),
                                (LAS float*)(lds + RING_BYTES), TG / 256, l == DEPTH - 1};
                  pg8::gemm_phase<pg8::EpiPM, pg8::StaticOrder, true, true>(lds, gm, S, E); });
        }
    }
#undef RUN
#undef a
}

#ifndef ONE_LAUNCH
#define ONE_LAUNCH 1
#endif
extern "C" void kernel_launch(void* const* d_in, const int* in_sizes, int n_in, void* d_out, int out_size, void* d_ws, size_t ws_size, hipStream_t stream) {
    static int grid = 0;
    if (grid == 0) {
        if (n_in != 18 || ws_size < WS_END || out_size != 2 * 32768 * DM) { fprintf(stderr, "kernel_launch: unexpected shapes (n_in %d, out %d, ws %zu; need ws >= %zu)\n", n_in, out_size, ws_size, (size_t)WS_END); grid = -1; return; }
        int dev = 0, cus = 0;
        if (hipGetDevice(&dev) != hipSuccess || hipDeviceGetAttribute(&cus, hipDeviceAttributeMultiprocessorCount, dev) != hipSuccess) { grid = -1; return; }
        if (hipFuncSetAttribute((const void*)fwd, hipFuncAttributeMaxDynamicSharedMemorySize, LDS_BYTES) != hipSuccess) { fprintf(stderr, "kernel_launch: hipFuncSetAttribute failed\n"); grid = -1; return; }
        int per_cu = 0;
        if (hipOccupancyMaxActiveBlocksPerMultiprocessor(&per_cu, (const void*)fwd, NTHR, LDS_BYTES) != hipSuccess || per_cu < 1) { fprintf(stderr, "kernel_launch: occupancy query says %d\n", per_cu); }
        (void)hipGetLastError();
        grid = cus;
    }
    if (grid < 0) return;
    (void)hipMemsetAsync((char*)d_ws + WS_CTL, 0, CTL_ZERO_BYTES, stream);
    Args a{};
    for (int i = 0; i < 18; ++i) a.in[i] = (const float*)d_in[i];
    a.out = (float*)d_out; a.ws = (unsigned char*)d_ws;
    if (ONE_LAUNCH) { a.s_lo = 0; a.s_hi = NSTEPS; hipLaunchKernelGGL(fwd, dim3(grid), dim3(NTHR), LDS_BYTES, stream, a); }
    else for (int s = 0; s < NSTEPS; ++s) { a.s_lo = s; a.s_hi = s + 1; hipLaunchKernelGGL(fwd, dim3(grid), dim3(NTHR), LDS_BYTES, stream, a); }
}
```
